# Optimizing an MI355X kernel written in HIP

```python
import math
import jax, jax.numpy as jnp
from jax import lax
import numpy as np

D_MODEL = 1024
BATCH = 32
SEQ = 256
DEPTH = 2
DEC_BATCH = 2
DEC_SEQ = 4096
PAST_LEN = 256

GRID_W = 64
HEAD_DIM = 64
GQA_WIDTH = D_MODEL // 2
DIFF_WIDTH = D_MODEL // 4
HGRN_WIDTH = D_MODEL // 4
GQA_Q_HEADS = GQA_WIDTH // HEAD_DIM
GQA_KV_HEADS = 2
GQA_GROUP = GQA_Q_HEADS // GQA_KV_HEADS
DIFF_HEADS = DIFF_WIDTH // HEAD_DIM
DIFF_QK_DIM = HEAD_DIM // 2
HGRN_HEADS = HGRN_WIDTH // HEAD_DIM
HGRN_KEY_DIM = HEAD_DIM
HGRN_VAL_DIM = HEAD_DIM
MIX_WIDTH = GQA_WIDTH + DIFF_WIDTH + HGRN_WIDTH
SPLIT_SIZES = (GQA_WIDTH, GQA_KV_HEADS * HEAD_DIM, GQA_KV_HEADS * HEAD_DIM, GQA_WIDTH,
               DIFF_WIDTH, DIFF_WIDTH, DIFF_WIDTH, DIFF_WIDTH,
               HGRN_WIDTH, HGRN_WIDTH, HGRN_WIDTH, HGRN_WIDTH, HGRN_WIDTH)
IN_WIDTH = sum(SPLIT_SIZES)
SPLIT_POINTS = tuple(sum(SPLIT_SIZES[:i + 1]) for i in range(len(SPLIT_SIZES) - 1))
Q_BLOCK = 128
SCAN_CHUNK = 64
ROPE_THETA = 10000.0
RMS_EPS = 1e-6
LN_EPS = 1e-5
FORGET_MIN = 1e-6
DEEPNORM_ALPHA = (2 * DEPTH) ** 0.25
DEEPNORM_BETA = (8 * DEPTH) ** -0.25

kernel_name = "hybrid_gqa_diffattn_hgrn2_diffusion_step"


def rms_norm(x, gain):
    xf = x.astype(jnp.float32)
    y = xf * lax.rsqrt(jnp.mean(xf * xf, axis=-1, keepdims=True) + RMS_EPS)
    return (y * gain.astype(jnp.float32)).astype(x.dtype)


def layer_norm(x, g, b):
    xf = x.astype(jnp.float32)
    mu = jnp.mean(xf, axis=-1, keepdims=True)
    xc = xf - mu
    var = jnp.mean(xc * xc, axis=-1, keepdims=True)
    return (xc * lax.rsqrt(var + LN_EPS) * g.astype(jnp.float32) + b.astype(jnp.float32)).astype(x.dtype)


def axial_rope_tables(n_tokens, dim):
    rows = n_tokens // GRID_W
    row = jnp.repeat(jnp.arange(rows, dtype=jnp.float32), GRID_W)
    col = jnp.tile(jnp.arange(GRID_W, dtype=jnp.float32), rows)
    quarter = dim // 4
    inv_freq = ROPE_THETA ** (-jnp.arange(quarter, dtype=jnp.float32) / quarter)
    ar = row[:, None] * inv_freq[None, :]
    ac = col[:, None] * inv_freq[None, :]
    ang = jnp.concatenate([ar, ar, ac, ac], axis=-1)
    return jnp.cos(ang), jnp.sin(ang)


def _rotate_half(u):
    u1, u2 = jnp.split(u, 2, axis=-1)
    return jnp.concatenate([-u2, u1], axis=-1)


def apply_axial_rope(x, cos, sin):
    shape = (1, cos.shape[0]) + (1,) * (x.ndim - 3) + (cos.shape[1],)
    c = cos.reshape(shape).astype(x.dtype)
    s = sin.reshape(shape).astype(x.dtype)
    xa, xb = jnp.split(x, 2, axis=-1)
    xr = jnp.concatenate([_rotate_half(xa), _rotate_half(xb)], axis=-1)
    return x * c + xr * s


def _query_blocks(q):
    b, n = q.shape[:2]
    q = q.reshape((b, n // Q_BLOCK, Q_BLOCK) + q.shape[2:])
    return jnp.moveaxis(q, 1, 0)


def _merge_blocks(o):
    o = jnp.moveaxis(o, 0, 1)
    return o.reshape((o.shape[0], o.shape[1] * o.shape[2]) + o.shape[3:])


def gqa_attention(q, k, v):
    b, n = q.shape[:2]
    qg = q.reshape(b, n, GQA_KV_HEADS, GQA_GROUP, HEAD_DIM)
    scale = HEAD_DIM ** -0.5

    def block(qb):
        s = jnp.einsum('bqgrd,bkgd->bgrqk', qb, k).astype(jnp.float32) * scale
        p = jax.nn.softmax(s, axis=-1).astype(v.dtype)
        return jnp.einsum('bgrqk,bkgd->bqgrd', p, v)

    o = _merge_blocks(lax.map(block, _query_blocks(qg)))
    return o.reshape(b, n, GQA_WIDTH)


def diff_attention(q, k, v, lam):
    scale = DIFF_QK_DIM ** -0.5

    def block(qb):
        s = jnp.einsum('bqhmd,bkhmd->bhmqk', qb, k).astype(jnp.float32) * scale
        p = jax.nn.softmax(s, axis=-1)
        a = p[:, :, 0] - lam * p[:, :, 1]
        return jnp.einsum('bhqk,bkhd->bqhd', a.astype(v.dtype), v)

    return _merge_blocks(lax.map(block, _query_blocks(q)))


def hgrn_scan(q, k, g, v, s0):
    b, n, h, _ = q.shape
    nc = n // SCAN_CHUNK

    def chunks(a):
        a = a.reshape(b, nc, SCAN_CHUNK, h, a.shape[-1])
        return jnp.transpose(a, (1, 0, 3, 2, 4))

    causal = jnp.tril(jnp.ones((SCAN_CHUNK, SCAN_CHUNK), dtype=bool))[:, :, None]

    def step(S, xs):
        qc, kc, gc, vc = xs
        G = jnp.cumsum(gc, axis=2)
        inter = jnp.einsum('bhck,bhkv->bhcv', qc * jnp.exp(G), S)
        diff = G[:, :, :, None, :] - G[:, :, None, :, :]
        decay = jnp.where(causal, jnp.exp(jnp.where(causal, diff, 0.0)), 0.0)
        A = jnp.einsum('bhtk,bhsk,bhtsk->bhts', qc, kc, decay)
        intra = jnp.einsum('bhts,bhsv->bhtv', A, vc)
        G_last = G[:, :, -1:, :]
        S_new = (jnp.exp(G_last[:, :, 0, :])[..., None] * S
                 + jnp.einsum('bhsk,bhsv->bhkv', kc * jnp.exp(G_last - G), vc))
        return S_new, inter + intra

    S_fin, o = lax.scan(step, s0, (chunks(q), chunks(k), chunks(g), chunks(v)))
    o = jnp.transpose(o, (1, 0, 3, 2, 4)).reshape(b, n, h, v.shape[-1])
    return o, S_fin


def hgrn_gates(z, lb):
    b, n, _ = z.shape
    z = z.reshape(b, n, HGRN_HEADS, HGRN_KEY_DIM).astype(jnp.float32)
    lb = lb.reshape(HGRN_HEADS, HGRN_KEY_DIM)
    k = (1.0 - lb) * jax.nn.sigmoid(-z)
    f = lb + (1.0 - lb) * jax.nn.sigmoid(z)
    g = jnp.log(jnp.maximum(f, FORGET_MIN))
    return k, g


def modulation(cond, w_ada_l, b_ada_l):
    m = jnp.einsum('bd,de->be', jax.nn.silu(cond), w_ada_l) + b_ada_l
    shift, scale, gate = jnp.split(m, 3, axis=-1)
    return shift[:, None, :], scale[:, None, :], gate[:, None, :]


def mixer(h, ctx, rope, lam_init, lb, w_in, q_norm, k_norm, lam_p, subln, hg_norm, w_out):
    b, n, _ = h.shape
    parts = jnp.split(jnp.einsum('bnd,de->bne', h, w_in), SPLIT_POINTS, axis=-1)
    a_q, a_k, a_v, a_g, d_q, d_k, d_v, d_g, r_q, r_ff, r_fb, r_i, r_g = parts

    a_q = rms_norm(a_q.reshape(b, n, GQA_Q_HEADS, HEAD_DIM), q_norm)
    a_k = rms_norm(a_k.reshape(b, n, GQA_KV_HEADS, HEAD_DIM), k_norm)
    a_v = a_v.reshape(b, n, GQA_KV_HEADS, HEAD_DIM)
    d_q = d_q.reshape(b, n, DIFF_HEADS, 2, DIFF_QK_DIM)
    d_k = d_k.reshape(b, n, DIFF_HEADS, 2, DIFF_QK_DIM)
    d_v = d_v.reshape(b, n, DIFF_HEADS, HEAD_DIM)

    if ctx is None:
        ka, va, kd, vd = a_k, a_v, d_k, d_v
        s0_f = jnp.zeros((b, HGRN_HEADS, HGRN_KEY_DIM, HGRN_VAL_DIM), jnp.float32)
        s0_b = s0_f
    else:
        cg_k, cg_v, cd_k, cd_v, st = ctx
        (cos_a, sin_a), (cos_d, sin_d) = rope
        a_q = apply_axial_rope(a_q, cos_a, sin_a)
        a_k = apply_axial_rope(a_k, cos_a, sin_a)
        d_q = apply_axial_rope(d_q, cos_d, sin_d)
        d_k = apply_axial_rope(d_k, cos_d, sin_d)
        ka = jnp.concatenate([cg_k.astype(a_k.dtype), a_k], axis=1)
        va = jnp.concatenate([cg_v.astype(a_v.dtype), a_v], axis=1)
        cd_k = cd_k.reshape(cd_k.shape[:2] + (DIFF_HEADS, 2, DIFF_QK_DIM))
        kd = jnp.concatenate([cd_k.astype(d_k.dtype), d_k], axis=1)
        vd = jnp.concatenate([cd_v.astype(d_v.dtype), d_v], axis=1)
        s0_f = st[:, 0].astype(jnp.float32)
        s0_b = st[:, 1].astype(jnp.float32)

    out_a = gqa_attention(a_q, ka, va) * jax.nn.silu(a_g)

    lp = lam_p.astype(jnp.float32)
    lam = jnp.exp(jnp.sum(lp[0] * lp[1])) - jnp.exp(jnp.sum(lp[2] * lp[3])) + lam_init
    o_d = diff_attention(d_q, kd, vd, lam)
    o_d = rms_norm(o_d, subln) * (1.0 - lam_init)
    out_d = o_d.reshape(b, n, DIFF_WIDTH) * jax.nn.silu(d_g)

    q_r = jax.nn.silu(r_q).reshape(b, n, HGRN_HEADS, HGRN_KEY_DIM).astype(jnp.float32)
    v_r = r_i.reshape(b, n, HGRN_HEADS, HGRN_VAL_DIM).astype(jnp.float32)
    k_f, g_f = hgrn_gates(r_ff, lb[0])
    k_b, g_b = hgrn_gates(r_fb, lb[1])
    o_f, sf = hgrn_scan(q_r, k_f, g_f, v_r, s0_f)
    flip = lambda a: jnp.flip(a, axis=1)
    o_b, sb = hgrn_scan(flip(q_r), flip(k_b), flip(g_b), flip(v_r), s0_b)
    o_r = rms_norm(o_f + flip(o_b), hg_norm).astype(h.dtype)
    out_r = o_r.reshape(b, n, HGRN_WIDTH) * jax.nn.silu(r_g)

    y = jnp.einsum('bne,ed->bnd', jnp.concatenate([out_a, out_d, out_r], axis=-1), w_out)
    if ctx is None:
        ctx_out = (a_k, a_v, d_k.reshape(b, n, DIFF_HEADS, HEAD_DIM), d_v,
                   jnp.stack([sf, sb], axis=1).astype(h.dtype))
        return y, ctx_out
    return y, None


def setup_inputs(seed: int = 0) -> dict:
    key = jax.random.key(seed)
    ks = jax.random.split(key, 24)
    f32 = jnp.float32
    nrm = lambda k, shape: jax.random.normal(k, shape, f32)
    s_in = D_MODEL ** -0.5
    return {
        "x_prompt": nrm(ks[0], (BATCH, SEQ, D_MODEL)),
        "x_sample": nrm(ks[1], (DEC_BATCH, DEC_SEQ, D_MODEL)),
        "cache_gqa_k": nrm(ks[2], (DEC_BATCH, DEPTH, PAST_LEN, GQA_KV_HEADS, HEAD_DIM)),
        "cache_gqa_v": nrm(ks[3], (DEC_BATCH, DEPTH, PAST_LEN, GQA_KV_HEADS, HEAD_DIM)),
        "cache_diff_k": nrm(ks[4], (DEC_BATCH, DEPTH, PAST_LEN, DIFF_HEADS, HEAD_DIM)),
        "cache_diff_v": nrm(ks[5], (DEC_BATCH, DEPTH, PAST_LEN, DIFF_HEADS, HEAD_DIM)),
        "state_hgrn": 0.5 * nrm(ks[6], (DEC_BATCH, DEPTH, 2, HGRN_HEADS, HGRN_KEY_DIM, HGRN_VAL_DIM)),
        "c": nrm(ks[7], (DEC_BATCH, D_MODEL)),
        "c_ctx": nrm(ks[8], (D_MODEL,)),
        "w_ada": 0.5 * s_in * nrm(ks[9], (DEPTH, D_MODEL, 3 * D_MODEL)),
        "b_ada": 0.02 * nrm(ks[10], (DEPTH, 3 * D_MODEL)),
        "w_in": s_in * nrm(ks[11], (DEPTH, D_MODEL, IN_WIDTH)),
        "gqa_q_norm": 1.0 + 0.02 * nrm(ks[12], (DEPTH, HEAD_DIM)),
        "gqa_k_norm": 1.0 + 0.02 * nrm(ks[13], (DEPTH, HEAD_DIM)),
        "diff_lambda": 0.1 * nrm(ks[14], (DEPTH, 4, DIFF_QK_DIM)),
        "diff_subln": 1.0 + 0.02 * nrm(ks[15], (DEPTH, HEAD_DIM)),
        "hgrn_lower_bounds": 0.1 * nrm(ks[16], (DEPTH, 2, HGRN_WIDTH)),
        "hgrn_norm": 1.0 + 0.02 * nrm(ks[17], (DEPTH, HEAD_DIM)),
        "w_out": DEEPNORM_BETA * MIX_WIDTH ** -0.5 * nrm(ks[18], (DEPTH, MIX_WIDTH, D_MODEL)),
        "ln_g": 1.0 + 0.02 * nrm(ks[19], (DEPTH, D_MODEL)),
        "ln_b": 0.02 * nrm(ks[20], (DEPTH, D_MODEL)),
    }


def reference(x_prompt, x_sample, cache_gqa_k, cache_gqa_v, cache_diff_k, cache_diff_v, state_hgrn,
              c, c_ctx, w_ada, b_ada, w_in, gqa_q_norm, gqa_k_norm, diff_lambda, diff_subln,
              hgrn_lower_bounds, hgrn_norm, w_out, ln_g, ln_b):
    lbs = jax.nn.softmax(hgrn_lower_bounds.astype(jnp.float32), axis=0)
    lbs = jnp.cumsum(lbs, axis=0) - lbs[0:1]

    x = x_prompt
    gk_l, gv_l, dk_l, dv_l, st_l = [], [], [], [], []
    for l in range(DEPTH):
        lam_init = 0.8 - 0.6 * math.exp(-0.3 * l)
        shift, scale, gate = modulation(c_ctx[None, :], w_ada[l], b_ada[l])
        h = x * (1.0 + scale) + shift
        y, (gk, gv, dk, dv, st) = mixer(h, None, None, lam_init, lbs[l], w_in[l], gqa_q_norm[l],
                                        gqa_k_norm[l], diff_lambda[l], diff_subln[l], hgrn_norm[l], w_out[l])
        x = layer_norm(DEEPNORM_ALPHA * x + gate * y, ln_g[l], ln_b[l])
        gk_l.append(gk); gv_l.append(gv); dk_l.append(dk); dv_l.append(dv); st_l.append(st)
    y_prompt = x
    new_gqa_k = jnp.stack(gk_l, axis=1)
    new_gqa_v = jnp.stack(gv_l, axis=1)
    new_diff_k = jnp.stack(dk_l, axis=1)
    new_diff_v = jnp.stack(dv_l, axis=1)
    new_state_hgrn = jnp.stack(st_l, axis=1)

    n_lat = x_sample.shape[1]
    rope = (axial_rope_tables(n_lat, HEAD_DIM), axial_rope_tables(n_lat, DIFF_QK_DIM))
    x = x_sample
    for l in range(DEPTH):
        lam_init = 0.8 - 0.6 * math.exp(-0.3 * l)
        shift, scale, gate = modulation(c, w_ada[l], b_ada[l])
        h = x * (1.0 + scale) + shift
        ctx = (cache_gqa_k[:, l], cache_gqa_v[:, l], cache_diff_k[:, l], cache_diff_v[:, l], state_hgrn[:, l])
        y, _ = mixer(h, ctx, rope, lam_init, lbs[l], w_in[l], gqa_q_norm[l], gqa_k_norm[l],
                     diff_lambda[l], diff_subln[l], hgrn_norm[l], w_out[l])
        x = layer_norm(DEEPNORM_ALPHA * x + gate * y, ln_g[l], ln_b[l])
    y_sample = x
    return (y_prompt, y_sample, new_gqa_k, new_gqa_v, new_diff_k, new_diff_v, new_state_hgrn)
```

```cpp
#include <hip/hip_runtime.h>
#include <hip/hip_cooperative_groups.h>
#include <cstdio>
#include <cstdint>
namespace cg = cooperative_groups;
#define DI __device__ __forceinline__
typedef unsigned short bf16_t;
typedef short s16x8 __attribute__((ext_vector_type(8)));
typedef short s16x4 __attribute__((ext_vector_type(4)));
typedef float f32x4 __attribute__((ext_vector_type(4)));
typedef float f32x2 __attribute__((ext_vector_type(2)));
typedef unsigned u32x4 __attribute__((ext_vector_type(4)));
typedef unsigned u32x2 __attribute__((ext_vector_type(2)));
typedef __bf16 bf2_t __attribute__((ext_vector_type(2)));
#define LAS __attribute__((address_space(3)))

struct Params {
  const float *xp, *xs, *cgk, *cgv, *cdk, *cdv, *st, *c, *cctx, *wada, *bada, *win, *qn, *kn, *dlam, *dsub, *hlb, *hnorm, *wout, *lng, *lnb;
  float* out; unsigned char* ws;
};

constexpr size_t OFF_MOD = 0;
constexpr size_t OFF_LBS = 73728;
constexpr size_t OFF_LAM = OFF_LBS + 4096;
constexpr size_t OFF_T64C = OFF_LAM + 256;
constexpr size_t OFF_T64S = OFF_T64C + 4096;
constexpr size_t OFF_T32C = OFF_T64S + 4096;
constexpr size_t OFF_T32S = OFF_T32C + 2048;
constexpr size_t OFF_BAR = 131072;
constexpr size_t OFF_WINT = 1u << 20;
constexpr size_t OFF_WOUTT = OFF_WINT + 14680064;
constexpr size_t OFF_H = OFF_WOUTT + 4194304;
constexpr size_t OFF_QA = OFF_H + 33554432;
constexpr size_t OFF_MIX = OFF_QA + 16777216;
constexpr size_t OFF_QD = OFF_MIX + 33554432;
constexpr size_t OFF_KA_CTX = OFF_QD + 8388608;
constexpr size_t OFF_VTA_CTX = OFF_KA_CTX + 2097152;
constexpr size_t OFF_KD_CTX = OFF_VTA_CTX + 2097152;
constexpr size_t OFF_VTD_CTX = OFF_KD_CTX + 4194304;
constexpr size_t OFF_KA_LAT = OFF_VTD_CTX + 4194304;
constexpr size_t OFF_VTA_LAT = OFF_KA_LAT + 4456448;
constexpr size_t OFF_KD_LAT = OFF_VTA_LAT + 4456448;
constexpr size_t OFF_VTD_LAT = OFF_KD_LAT + 8912896;
constexpr size_t OFF_HQ = OFF_VTD_LAT + 8912896;
constexpr size_t OFF_HV = OFF_HQ + 8388608;
constexpr size_t OFF_GF = OFF_HV + 8388608;
constexpr size_t OFF_GB = OFF_GF + 16777216;
constexpr size_t OFF_HS = OFF_GB + 16777216;
constexpr size_t OFF_HP = OFF_HS + 33554432;
constexpr size_t WS_END = OFF_HP + 524288;

constexpr size_t OUT_GK = 16777216, OUT_GV = 18874368, OUT_DK = 20971520, OUT_DV = 25165824, OUT_ST = 29360128;

constexpr int LD = 80;
constexpr int NT = 512;
constexpr int SMEM_BYTES = 131072;
constexpr int HALF_LDS = 43008;

DI unsigned pk(float a, float b) { f32x2 v = {a, b}; bf2_t r = __builtin_convertvector(v, bf2_t); return __builtin_bit_cast(unsigned, r); }
DI bf16_t f2bf(float a) { return (bf16_t)(pk(a, 0.f) & 0xffffu); }
DI float bf2f(bf16_t u) { return __uint_as_float((unsigned)u << 16); }
DI float bflo(unsigned u) { return __uint_as_float(u << 16); }
DI float bfhi(unsigned u) { return __uint_as_float(u & 0xffff0000u); }
DI u32x2 pk4(f32x4 v) { u32x2 r; r.x = pk(v[0], v[1]); r.y = pk(v[2], v[3]); return r; }
DI f32x4 unpk4(u32x2 u) { f32x4 r; r[0] = bflo(u.x); r[1] = bfhi(u.x); r[2] = bflo(u.y); r[3] = bfhi(u.y); return r; }
DI float siluf(float x) { return x * __builtin_amdgcn_rcpf(1.f + __expf(-x)); }
DI float sigmf(float x) { return __builtin_amdgcn_rcpf(1.f + __expf(-x)); }
DI f32x4 silu4(f32x4 v) { f32x4 r; for (int j = 0; j < 4; ++j) r[j] = siluf(v[j]); return r; }
#define MFMA(a, b, c) __builtin_amdgcn_mfma_f32_16x16x32_bf16((a), (b), (c), 0, 0, 0)
#define WSP(T, off) ((T*)(P.ws + (off)))
DI int otid() { int t = threadIdx.x; asm volatile("" : "+v"(t)); return t; }


#define XB_TMO      128
#define XB_XCNT(j)  (256  + 64 * (j))
#define XB_XSUB(j)  (1280 + 64 * (j))
#define XB_XGEN(j)  (2304 + 64 * (j))
#define XB_TOP      3328
#define XB_TOPGEN   3392
#define XCD_BAR_WORDS 3456
#define XB_SPIN_CAP (1u << 22)
DI unsigned xb_ld(unsigned* p)              { return __hip_atomic_load(p, __ATOMIC_RELAXED, __HIP_MEMORY_SCOPE_AGENT); }
DI unsigned xb_add(unsigned* p, unsigned v) { return __hip_atomic_fetch_add(p, v, __ATOMIC_RELAXED, __HIP_MEMORY_SCOPE_AGENT); }
DI unsigned xb_xcc_id() { return (unsigned)__builtin_amdgcn_s_getreg((3 << 11) | 20) & 0xFu; }
#define XB_SPIN(cond, bar) do { unsigned _sp = 0; while (cond) { __builtin_amdgcn_s_sleep(1); \
    if ((++_sp & 255u) == 0u) { if (xb_ld(&(bar)[XB_TMO])) break; if (_sp > XB_SPIN_CAP) { atomicAdd(&(bar)[XB_TMO], 1u); break; } } } } while (0)
struct XcdBarrier { unsigned* bar; unsigned x; volatile LAS unsigned* st; };
DI XcdBarrier xcd_barrier_post(unsigned* bar, volatile LAS unsigned* st) {
  XcdBarrier b; b.bar = bar; b.x = xb_xcc_id(); b.st = st;
  if (threadIdx.x == 0) (void)xb_add(&bar[XB_XCNT(b.x)], 1u);
  return b;
}
DI void xcd_barrier_complete(unsigned* bar, unsigned x, unsigned& nloc, unsigned& nx) {
  const unsigned G = gridDim.x * gridDim.y * gridDim.z;
  unsigned sum, cnt, mine, sp = 0u;
  for (;;) {
    sum = 0u; cnt = 0u; mine = 0u;
#pragma unroll
    for (unsigned j = 0; j < 16; ++j) { const unsigned c = xb_ld(&bar[XB_XCNT(j)]); sum += c; cnt += (c > 0u) ? 1u : 0u; mine = (j == x) ? c : mine; }
    if (sum == G) break;
    __builtin_amdgcn_s_sleep(1);
    if ((++sp & 255u) == 0u) { if (xb_ld(&bar[XB_TMO])) break; if (sp > XB_SPIN_CAP) { atomicAdd(&bar[XB_TMO], 1u); break; } }
  }
  nloc = mine > 0u ? mine : 1u; nx = cnt > 0u ? cnt : 1u;
}
DI void xcd_barrier(const XcdBarrier& b) {
  asm volatile("s_waitcnt vmcnt(0)" ::: "memory");
  __syncthreads();
  if (threadIdx.x == 0) {
    unsigned* bar = b.bar;
    __builtin_amdgcn_s_waitcnt(0);
    unsigned nloc = b.st[0], nx = b.st[1];
    if (nloc == 0u) { xcd_barrier_complete(bar, b.x, nloc, nx); b.st[0] = nloc; b.st[1] = nx; }
    const unsigned old = xb_add(&bar[XB_XSUB(b.x)], 1u);
    const unsigned gen = old / nloc;
    if (old + 1u == (gen + 1u) * nloc) {
      __builtin_amdgcn_fence(__ATOMIC_RELEASE, "agent");
      asm volatile("s_waitcnt vmcnt(0)" ::: "memory");
      const unsigned og = xb_add(&bar[XB_TOP], 1u);
      const unsigned tg = og / nx;
      if (og + 1u == (tg + 1u) * nx) xb_add(&bar[XB_TOPGEN], 1u);
      else XB_SPIN(xb_ld(&bar[XB_TOPGEN]) == tg, bar);
      __builtin_amdgcn_fence(__ATOMIC_ACQUIRE, "agent");
      xb_add(&bar[XB_XGEN(b.x)], 1u);
      asm volatile("s_waitcnt vmcnt(0)" ::: "memory");
    } else {
      XB_SPIN(xb_ld(&bar[XB_XGEN(b.x)]) == gen, bar);
      __builtin_amdgcn_fence(__ATOMIC_ACQUIRE, "agent");
      asm volatile("s_waitcnt vmcnt(0)" ::: "memory");
    }
  }
  __syncthreads();
}

constexpr int P0_ITEMS = 192 + 1152 + 192 + 1;
DI void p0_item(const Params& P, int it, unsigned char* smem) {
  const int tid = otid();
  if (it < 192) {
    const int l = it / 96, rem = it % 96, kc = rem / 6, cc = rem % 6;
    float* sil = (float*)smem;
    __syncthreads();
    if (tid < 192) { const int cnd = tid >> 6, kk = tid & 63, k = kc * 64 + kk; const float cv = cnd == 0 ? P.cctx[k] : P.c[(cnd - 1) * 1024 + k]; sil[tid] = siluf(cv); }
    __syncthreads();
    const int col = cc * NT + tid;
    const float* w = P.wada + ((size_t)l * 1024 + kc * 64) * 3072 + col;
    float a0 = 0.f, a1 = 0.f, a2 = 0.f;
#pragma unroll 8
    for (int kk = 0; kk < 64; ++kk) { const float wv = w[(size_t)kk * 3072]; a0 += sil[kk] * wv; a1 += sil[64 + kk] * wv; a2 += sil[128 + kk] * wv; }
    const float bb = kc == 0 ? P.bada[l * 3072 + col] : 0.f;
    float* mod = WSP(float, OFF_MOD) + (size_t)l * 9216 + col;
    atomicAdd(mod, a0 + bb); atomicAdd(mod + 3072, a1 + bb); atomicAdd(mod + 6144, a2 + bb);
    return;
  }
  it -= 192;
  if (it < 1152) {
    const int hb = tid >> 8, tl = tid & 255, it2 = 2 * it + hb;
    const float* src; bf16_t* dst; int N, tn, tk;
    if (it2 < 1792) { const int l = it2 / 896, r2 = it2 % 896; tn = r2 / 16; tk = r2 % 16; N = 3584; src = P.win + (size_t)l * 1024 * 3584; dst = WSP(bf16_t, OFF_WINT) + (size_t)l * 3584 * 1024; }
    else { const int i2 = it2 - 1792, l = i2 / 256, r2 = i2 % 256; tn = r2 / 16; tk = r2 % 16; N = 1024; src = P.wout + (size_t)l * 1024 * 1024; dst = WSP(bf16_t, OFF_WOUTT) + (size_t)l * 1024 * 1024; }
    float* tile = (float*)smem + hb * 4160;
    float rg[16];
#pragma unroll
    for (int u = 0; u < 16; ++u) { const int e = tl + 256 * u, kk = e >> 6, nn = e & 63; rg[u] = src[(size_t)(tk * 64 + kk) * N + tn * 64 + nn]; }
    __syncthreads();
#pragma unroll
    for (int u = 0; u < 16; ++u) { const int e = tl + 256 * u, kk = e >> 6, nn = e & 63; tile[kk * 65 + nn] = rg[u]; }
    __syncthreads();
#pragma unroll
    for (int u = 0; u < 8; ++u) { const int e = tl + 256 * u, nn = e >> 5, k2 = (e & 31) * 2;
      *(unsigned*)(dst + (size_t)(tn * 64 + nn) * 1024 + tk * 64 + k2) = pk(tile[k2 * 65 + nn], tile[(k2 + 1) * 65 + nn]); }
    return;
  }
  it -= 1152;
  if (it < 192) {
    for (int u = 0; u < 4096 / NT; ++u) {
      const int e = it * 4096 + u * NT + tid;
      if (e < 131072) {
        const int ci = e & 127, t = (e >> 7) & 255, b = (e >> 15) & 1, l = e >> 16;
        WSP(bf16_t, OFF_KA_LAT)[((size_t)(l * 2 + b) * 4352 + t) * 128 + ci] = f2bf(P.cgk[((size_t)(b * 2 + l) * 256 + t) * 128 + ci]);
      } else if (e < 262144) {
        const int e2 = e - 131072, t = e2 & 255, d = (e2 >> 8) & 63, kvh = (e2 >> 14) & 1, b = (e2 >> 15) & 1, l = e2 >> 16;
        WSP(bf16_t, OFF_VTA_LAT)[(((size_t)(l * 2 + b) * 2 + kvh) * 64 + d) * 4352 + t] = f2bf(P.cgv[((size_t)(b * 2 + l) * 256 + t) * 128 + kvh * 64 + d]);
      } else if (e < 524288) {
        const int e2 = e - 262144, ci = e2 & 255, t = (e2 >> 8) & 255, b = (e2 >> 16) & 1, l = e2 >> 17;
        WSP(bf16_t, OFF_KD_LAT)[((size_t)(l * 2 + b) * 4352 + t) * 256 + ci] = f2bf(P.cdk[((size_t)(b * 2 + l) * 256 + t) * 256 + ci]);
      } else {
        const int e2 = e - 524288, t = e2 & 255, d = (e2 >> 8) & 63, h = (e2 >> 14) & 3, b = (e2 >> 16) & 1, l = e2 >> 17;
        WSP(bf16_t, OFF_VTD_LAT)[(((size_t)(l * 2 + b) * 4 + h) * 64 + d) * 4352 + t] = f2bf(P.cdv[((size_t)(b * 2 + l) * 256 + t) * 256 + h * 64 + d]);
      }
    }
    return;
  }
  float* lbs = WSP(float, OFF_LBS);
  for (int e = tid; e < 512; e += NT) {
    const int dir = e >> 8, ci = e & 255;
    const float a0 = P.hlb[(0 * 2 + dir) * 256 + ci], a1 = P.hlb[(1 * 2 + dir) * 256 + ci], mx = fmaxf(a0, a1);
    const float e0 = expf(a0 - mx), e1 = expf(a1 - mx);
    lbs[(0 * 2 + dir) * 256 + ci] = 0.f; lbs[(1 * 2 + dir) * 256 + ci] = e1 / (e0 + e1);
  }
  if (tid < 2) {
    const int l = tid; float s1 = 0.f, s2 = 0.f;
    for (int i = 0; i < 32; ++i) { s1 += P.dlam[(l * 4 + 0) * 32 + i] * P.dlam[(l * 4 + 1) * 32 + i]; s2 += P.dlam[(l * 4 + 2) * 32 + i] * P.dlam[(l * 4 + 3) * 32 + i]; }
    const float li = 0.8f - 0.6f * expf(-0.3f * (float)l);
    WSP(float, OFF_LAM)[l] = expf(s1) - expf(s2) + li;
  }
  for (int e = tid; e < 1024; e += NT) { const int pos = e >> 4, i = e & 15; const float inv = powf(10000.f, -(float)i / 16.f), ang = (float)pos * inv; WSP(float, OFF_T64C)[e] = cosf(ang); WSP(float, OFF_T64S)[e] = sinf(ang); }
  for (int e = tid; e < 512; e += NT) { const int pos = e >> 3, i = e & 7; const float inv = powf(10000.f, -(float)i / 8.f), ang = (float)pos * inv; WSP(float, OFF_T32C)[e] = cosf(ang); WSP(float, OFF_T32S)[e] = sinf(ang); }
}

DI void p0b(const Params& P) {
  const int gtid = blockIdx.x * NT + threadIdx.x, gsz = gridDim.x * NT;
  const float* mod = WSP(float, OFF_MOD);
  bf16_t* H = WSP(bf16_t, OFF_H);
  for (int e = gtid; e < 16384 * 128; e += gsz) {
    const int token = e >> 7, c8 = (e & 127) * 8;
    const int cond = token < 8192 ? 0 : 1 + ((token - 8192) >> 12);
    const float* xr = (token < 8192 ? P.xp + (size_t)token * 1024 : P.xs + (size_t)(token - 8192) * 1024) + c8;
    const float* sh = mod + cond * 3072 + c8; const float* sc = sh + 1024;
    const f32x4 x0 = *(const f32x4*)xr, x1 = *(const f32x4*)(xr + 4);
    const f32x4 h0 = x0 * (*(const f32x4*)sc + 1.f) + *(const f32x4*)sh, h1 = x1 * (*(const f32x4*)(sc + 4) + 1.f) + *(const f32x4*)(sh + 4);
    u32x4 o; o.x = pk(h0[0], h0[1]); o.y = pk(h0[2], h0[3]); o.z = pk(h1[0], h1[1]); o.w = pk(h1[2], h1[3]);
    *(u32x4*)(H + (size_t)token * 1024 + c8) = o;
  }
}

template <int MT>
DI void gemm_tile(const bf16_t* __restrict__ A, const bf16_t* __restrict__ Bt, int K, int row0, int col0, unsigned char* smem, f32x4 (&acc)[MT][4]) {
  const int tid = otid(), lane = tid & 63, w = tid >> 6, wm = w >> 2, wn = w & 3, r = lane & 15, quad = lane >> 4;
  const bf16_t* Ag = A + (size_t)row0 * K; const bf16_t* Bg = Bt + (size_t)col0 * K;
#pragma unroll
  for (int mt = 0; mt < MT; ++mt)
#pragma unroll
    for (int nt = 0; nt < 4; ++nt) acc[mt][nt] = (f32x4){0.f, 0.f, 0.f, 0.f};
  const int srow = tid >> 3, sk = ((tid & 7) ^ (srow & 7)) * 8;
  const bf16_t* ga = Ag + (size_t)srow * K + sk; const bf16_t* gb = Bg + (size_t)srow * K + sk;
  const size_t pstep = (size_t)64 * K;
  const int nk = K / 64;
#define GT_DMA(st, k0) do { LAS unsigned char* lb_ = (LAS unsigned char*)smem + (st) * 65536 + w * 1024; \
    _Pragma("unroll") for (int i = 0; i < MT / 2; ++i) __builtin_amdgcn_global_load_lds((const unsigned*)(ga + i * pstep + (k0)), (LAS unsigned*)(lb_ + i * 8192), 16, 0, 0); \
    _Pragma("unroll") for (int i = 0; i < 4; ++i) __builtin_amdgcn_global_load_lds((const unsigned*)(gb + i * pstep + (k0)), (LAS unsigned*)(lb_ + 32768 + i * 8192), 16, 0, 0); } while (0)
  __syncthreads();
  GT_DMA(0, 0);
  asm volatile("s_waitcnt vmcnt(0)" ::: "memory");
  __syncthreads();
  const int sw = r & 7;
  for (int kt = 0; kt < nk; ++kt) {
    const int cur = kt & 1;
    if (kt + 1 < nk) GT_DMA(cur ^ 1, (kt + 1) * 64);
    const unsigned char* As = smem + cur * 65536; const unsigned char* Bs = As + 32768;
#pragma unroll
    for (int ks = 0; ks < 2; ++ks) {
      s16x8 af[MT], bfr[4];
      const int co = ((4 * ks + quad) ^ sw) * 16;
#pragma unroll
      for (int mt = 0; mt < MT; ++mt) af[mt] = *(const s16x8*)(As + (wm * 16 * MT + 16 * mt + r) * 128 + co);
#pragma unroll
      for (int nt = 0; nt < 4; ++nt) bfr[nt] = *(const s16x8*)(Bs + (wn * 64 + 16 * nt + r) * 128 + co);
#pragma unroll
      for (int mt = 0; mt < MT; ++mt)
#pragma unroll
        for (int nt = 0; nt < 4; ++nt) acc[mt][nt] = MFMA(bfr[nt], af[mt], acc[mt][nt]);
    }
    asm volatile("s_waitcnt vmcnt(0)" ::: "memory");
    __syncthreads();
  }
#undef GT_DMA
}

constexpr int LDT = 72;
DI void stage_row4(bf16_t* T, int mt, int nt, int lane, u32x2 v) { *(u32x2*)(T + (16 * (mt & 3) + (lane & 15)) * LDT + 16 * nt + 4 * (lane >> 4)) = v; }
DI void flush_rows(const bf16_t* T, bf16_t* __restrict__ g  , size_t stride, int lane) {
  asm volatile("s_waitcnt lgkmcnt(0)" ::: "memory");
#pragma unroll
  for (int u = 0; u < 8; ++u) { const int ch = u * 64 + lane, row = ch >> 3, k = ch & 7; *(u32x4*)(g + (size_t)row * stride + k * 8) = *(const u32x4*)(T + row * LDT + k * 8); }
  asm volatile("" ::: "memory");
}
#define FLUSH_IF(mt, gbase, stride) do { if (((mt) & 3) == 3) flush_rows(T, (gbase) + (size_t)(64 * ((mt) >> 2)) * (stride), (stride), lane); } while (0)

template <int MT>
DI void inproj_epi(const Params& P, int l, f32x4 (&acc)[MT][4], int rowb, int colb, int lane, unsigned char* smem_w) {
  bf16_t* T = (bf16_t*)smem_w;
  const int c = lane & 15, quad = lane >> 4;
  const bool lat = rowb >= 8192;
  bf16_t* mix = WSP(bf16_t, OFF_MIX);
  if (colb < 640) {
    const bool isq = colb < 512;
    const float* gain = (isq ? P.qn : P.kn) + l * 64;
    f32x4 gn[4];
#pragma unroll
    for (int nt = 0; nt < 4; ++nt) gn[nt] = *(const f32x4*)(gain + 16 * nt + 4 * quad);
#pragma unroll
    for (int mt = 0; mt < MT; ++mt) {
      const int token = rowb + 16 * mt + c;
      float ss = 0.f;
#pragma unroll
      for (int nt = 0; nt < 4; ++nt)
#pragma unroll
        for (int j = 0; j < 4; ++j) ss += acc[mt][nt][j] * acc[mt][nt][j];
      ss += __shfl_xor(ss, 16); ss += __shfl_xor(ss, 32);
      const float rinv = rsqrtf(ss * (1.f / 64.f) + 1e-6f);
      f32x4 v[4];
#pragma unroll
      for (int nt = 0; nt < 4; ++nt) v[nt] = acc[mt][nt] * rinv * gn[nt];
      const int n = (token - 8192) & 4095, bb = (token - 8192) >> 12;
      if (lat) {
        const int prow = n >> 6, pcol = n & 63;
        const f32x4 cr = *(const f32x4*)(WSP(float, OFF_T64C) + prow * 16 + 4 * quad), sr = *(const f32x4*)(WSP(float, OFF_T64S) + prow * 16 + 4 * quad);
        const f32x4 cc = *(const f32x4*)(WSP(float, OFF_T64C) + pcol * 16 + 4 * quad), sc = *(const f32x4*)(WSP(float, OFF_T64S) + pcol * 16 + 4 * quad);
        const f32x4 a0 = v[0] * cr - v[1] * sr, a1 = v[1] * cr + v[0] * sr, a2 = v[2] * cc - v[3] * sc, a3 = v[3] * cc + v[2] * sc;
        v[0] = a0; v[1] = a1; v[2] = a2; v[3] = a3;
      }
#pragma unroll
      for (int nt = 0; nt < 4; ++nt) stage_row4(T, mt, nt, lane, pk4(v[nt]));
      if (isq) FLUSH_IF(mt, WSP(bf16_t, OFF_QA) + (size_t)rowb * 512 + colb, 512);
      else {
        const int kc = colb - 512;
        if (!lat) {
          const int b = token >> 8, s = token & 255;
          float* o = P.out + OUT_GK + ((size_t)(b * 2 + l) * 256 + s) * 128 + kc + 4 * quad;
#pragma unroll
          for (int nt = 0; nt < 4; ++nt) *(f32x4*)(o + 16 * nt) = v[nt];
          FLUSH_IF(mt, WSP(bf16_t, OFF_KA_CTX) + (size_t)rowb * 128 + kc, 128);
        } else FLUSH_IF(mt, WSP(bf16_t, OFF_KA_LAT) + ((size_t)(l * 2 + ((rowb - 8192) >> 12)) * 4352 + 256 + ((rowb - 8192) & 4095)) * 128 + kc, 128);
      }
    }
  } else if (colb < 768) {
    const int vc = colb - 640, kvh = vc >> 6;
#pragma unroll
    for (int mt = 0; mt < MT; ++mt) {
      const int token = rowb + 16 * mt + c;
      bf16_t* dst; size_t dstr;
      if (!lat) {
        const int b = token >> 8, s = token & 255;
        float* o = P.out + OUT_GV + ((size_t)(b * 2 + l) * 256 + s) * 128 + vc + 4 * quad;
#pragma unroll
        for (int nt = 0; nt < 4; ++nt) *(f32x4*)(o + 16 * nt) = acc[mt][nt];
        dst = WSP(bf16_t, OFF_VTA_CTX) + ((size_t)(b * 2 + kvh) * 64) * 256 + s; dstr = 256;
      } else {
        const int n = (token - 8192) & 4095, bb = (token - 8192) >> 12;
        dst = WSP(bf16_t, OFF_VTA_LAT) + (((size_t)(l * 2 + bb) * 2 + kvh) * 64) * 4352 + 256 + n; dstr = 4352;
      }
#pragma unroll
      for (int nt = 0; nt < 4; ++nt)
#pragma unroll
        for (int j = 0; j < 4; ++j) dst[(size_t)(16 * nt + 4 * quad + j) * dstr] = f2bf(acc[mt][nt][j]);
    }
  } else if (colb < 1280 || (colb >= 2048 && colb < 2304) || colb >= 3328) {
    const int mc = colb < 1280 ? colb - 768 : (colb < 2304 ? 512 + colb - 2048 : 768 + colb - 3328);
#pragma unroll
    for (int mt = 0; mt < MT; ++mt) {
#pragma unroll
      for (int nt = 0; nt < 4; ++nt) stage_row4(T, mt, nt, lane, pk4(silu4(acc[mt][nt])));
      FLUSH_IF(mt, mix + (size_t)rowb * 1024 + mc, 1024);
    }
  } else if (colb < 1792) {
    const bool isq = colb < 1536;
#pragma unroll
    for (int mt = 0; mt < MT; ++mt) {
      const int token = rowb + 16 * mt + c;
      const int n = (token - 8192) & 4095, bb = (token - 8192) >> 12;
      f32x4 v[4];
#pragma unroll
      for (int nt = 0; nt < 4; ++nt) v[nt] = acc[mt][nt];
      if (lat) {
        const int prow = n >> 6, pcol = n & 63;
#pragma unroll
        for (int nt = 0; nt < 4; ++nt) {
          const int pos = (nt & 1) ? pcol : prow;
          const f32x4 cs = *(const f32x4*)(WSP(float, OFF_T32C) + pos * 8 + (quad & 1) * 4), sn = *(const f32x4*)(WSP(float, OFF_T32S) + pos * 8 + (quad & 1) * 4);
          f32x4 pr;
#pragma unroll
          for (int j = 0; j < 4; ++j) pr[j] = __shfl_xor(v[nt][j], 32);
          v[nt] = quad < 2 ? v[nt] * cs - pr * sn : v[nt] * cs + pr * sn;
        }
      }
#pragma unroll
      for (int nt = 0; nt < 4; ++nt) stage_row4(T, mt, nt, lane, pk4(v[nt]));
      if (isq) FLUSH_IF(mt, WSP(bf16_t, OFF_QD) + (size_t)rowb * 256 + (colb - 1280), 256);
      else {
        const int kc = colb - 1536;
        if (!lat) {
          const int b = token >> 8, s = token & 255;
          float* o = P.out + OUT_DK + ((size_t)(b * 2 + l) * 256 + s) * 256 + kc + 4 * quad;
#pragma unroll
          for (int nt = 0; nt < 4; ++nt) *(f32x4*)(o + 16 * nt) = v[nt];
          FLUSH_IF(mt, WSP(bf16_t, OFF_KD_CTX) + (size_t)rowb * 256 + kc, 256);
        } else FLUSH_IF(mt, WSP(bf16_t, OFF_KD_LAT) + ((size_t)(l * 2 + ((rowb - 8192) >> 12)) * 4352 + 256 + ((rowb - 8192) & 4095)) * 256 + kc, 256);
      }
    }
  } else if (colb < 2048) {
    const int vc = colb - 1792, h = vc >> 6;
#pragma unroll
    for (int mt = 0; mt < MT; ++mt) {
      const int token = rowb + 16 * mt + c;
      bf16_t* dst; size_t dstr;
      if (!lat) {
        const int b = token >> 8, s = token & 255;
        float* o = P.out + OUT_DV + ((size_t)(b * 2 + l) * 256 + s) * 256 + vc + 4 * quad;
#pragma unroll
        for (int nt = 0; nt < 4; ++nt) *(f32x4*)(o + 16 * nt) = acc[mt][nt];
        dst = WSP(bf16_t, OFF_VTD_CTX) + ((size_t)(b * 4 + h) * 64) * 256 + s; dstr = 256;
      } else {
        const int n = (token - 8192) & 4095, bb = (token - 8192) >> 12;
        dst = WSP(bf16_t, OFF_VTD_LAT) + (((size_t)(l * 2 + bb) * 4 + h) * 64) * 4352 + 256 + n; dstr = 4352;
      }
#pragma unroll
      for (int nt = 0; nt < 4; ++nt)
#pragma unroll
        for (int j = 0; j < 4; ++j) dst[(size_t)(16 * nt + 4 * quad + j) * dstr] = f2bf(acc[mt][nt][j]);
    }
  } else if (colb < 2560) {
#pragma unroll
    for (int mt = 0; mt < MT; ++mt) {
#pragma unroll
      for (int nt = 0; nt < 4; ++nt) stage_row4(T, mt, nt, lane, pk4(silu4(acc[mt][nt])));
      FLUSH_IF(mt, WSP(bf16_t, OFF_HQ) + (size_t)rowb * 256 + (colb - 2304), 256);
    }
  } else if (colb < 3072) {
    const int dir = colb < 2816 ? 0 : 1, cc0 = colb - (dir ? 2816 : 2560);
    float* G = WSP(float, dir ? OFF_GB : OFF_GF);
    f32x4 lb[4];
#pragma unroll
    for (int nt = 0; nt < 4; ++nt) lb[nt] = *(const f32x4*)(WSP(float, OFF_LBS) + (l * 2 + dir) * 256 + cc0 + 16 * nt + 4 * quad);
#pragma unroll
    for (int mt = 0; mt < MT; ++mt) {
      const int token = rowb + 16 * mt + c;
      float* dst = G + (size_t)token * 256 + cc0 + 4 * quad;
#pragma unroll
      for (int nt = 0; nt < 4; ++nt) {
        f32x4 g;
#pragma unroll
        for (int j = 0; j < 4; ++j) { const float f = lb[nt][j] + (1.f - lb[nt][j]) * sigmf(acc[mt][nt][j]); g[j] = logf(fmaxf(f, 1e-6f)); }
        *(f32x4*)(dst + 16 * nt) = g;
      }
    }
  } else {
#pragma unroll
    for (int mt = 0; mt < MT; ++mt) {
#pragma unroll
      for (int nt = 0; nt < 4; ++nt) stage_row4(T, mt, nt, lane, pk4(acc[mt][nt]));
      FLUSH_IF(mt, WSP(bf16_t, OFF_HV) + (size_t)rowb * 256 + (colb - 3072), 256);
    }
  }
}

DI void phase_inproj(const Params& P, int l, unsigned char* smem) {
  const bf16_t* A = WSP(bf16_t, OFF_H); const bf16_t* Bt = WSP(bf16_t, OFF_WINT) + (size_t)l * 3584 * 1024;
  const int xcd = blockIdx.x & 7, nbx = gridDim.x >> 3;
  for (int j = blockIdx.x >> 3; j < 96; j += nbx) {
    const int tid = otid(), lane = tid & 63, w = tid >> 6, wm = w >> 2, wn = w & 3;
    const int q = j & 31, pm = 8 * xcd + (q >> 2), pn = 4 * (j >> 5) + (q & 3);
    f32x4 acc[8][4];
    gemm_tile<8>(A, Bt, 1024, pm * 256, pn * 256, smem, acc);
    inproj_epi<8>(P, l, acc, pm * 256 + wm * 128, pn * 256 + wn * 64, lane, smem + w * 9216);
  }
  for (int j = blockIdx.x >> 3; j < 32; j += nbx) {
    const int tid = otid(), lane = tid & 63, w = tid >> 6, wm = w >> 2, wn = w & 3;
    const int pm = 8 * xcd + (j >> 2), pn = 12 + ((j >> 1) & 1), hm = j & 1;
    f32x4 acc[4][4];
    gemm_tile<4>(A, Bt, 1024, pm * 256 + hm * 128, pn * 256, smem, acc);
    inproj_epi<4>(P, l, acc, pm * 256 + hm * 128 + wm * 64, pn * 256 + wn * 64, lane, smem + w * 9216);
  }
}

DI void phase_outproj(const Params& P, int l, unsigned char* smem) {
  const bf16_t* A = WSP(bf16_t, OFF_MIX); const bf16_t* Bt = WSP(bf16_t, OFF_WOUTT) + (size_t)l * 1024 * 1024;
  const float* mod = WSP(float, OFF_MOD) + (size_t)l * 9216;
  const float alpha = 1.41421356237f;
  const int xcd = blockIdx.x & 7, nbx = gridDim.x >> 3;
  for (int j = blockIdx.x >> 3; j < 32; j += nbx) {
    const int tid = otid(), lane = tid & 63, w = tid >> 6, wm = w >> 2, wn = w & 3, c = lane & 15, quad = lane >> 4;
    const int pm = 8 * xcd + (j >> 2), pn = j & 3;
    f32x4 acc[8][4];
    gemm_tile<8>(A, Bt, 1024, pm * 256, pn * 256, smem, acc);
    const int rowb = pm * 256 + wm * 128, colb = pn * 256 + wn * 64;
#pragma unroll
    for (int mt = 0; mt < 8; ++mt) {
      const int token = rowb + 16 * mt + c;
      const int cond = token < 8192 ? 0 : 1 + ((token - 8192) >> 12);
      const float* xo = l == 0 ? (token < 8192 ? P.xp + (size_t)token * 1024 : P.xs + (size_t)(token - 8192) * 1024) : P.out + (size_t)token * 1024;
      bf16_t* vo = WSP(bf16_t, OFF_GF) + (size_t)token * 1024;
#pragma unroll
      for (int nt = 0; nt < 4; ++nt) {
        const int col = colb + 16 * nt + 4 * quad;
        const f32x4 g = *(const f32x4*)(mod + cond * 3072 + 2048 + col), xv = *(const f32x4*)(xo + col);
        *(u32x2*)(vo + col) = pk4(xv * alpha + g * acc[mt][nt]);
      }
    }
  }
}

DI void phase_ln(const Params& P, int l, int dry = 0) {
  const int lane = threadIdx.x & 63, gw = blockIdx.x * (NT / 64) + (threadIdx.x >> 6), nw = gridDim.x * (NT / 64);
  const float* g = P.lng + l * 1024; const float* b = P.lnb + l * 1024;
  const float* mod1 = WSP(float, OFF_MOD) + 9216;
  constexpr int R = 4;
  for (int row0 = gw; row0 < 16384; row0 += nw * R) {
    f32x4 v[R][4]; float s[R], q[R];
#pragma unroll
    for (int rr = 0; rr < R; ++rr) {
      const int row = row0 + rr * nw;
      if (row < 16384) {
        const bf16_t* vp = WSP(bf16_t, OFF_GF) + (size_t)row * 1024;
#pragma unroll
        for (int i = 0; i < 4; ++i) v[rr][i] = unpk4(*(const u32x2*)(vp + i * 256 + lane * 4));
      }
    }
#pragma unroll
    for (int rr = 0; rr < R; ++rr) {
      const int row = row0 + rr * nw;
      if (row >= 16384) continue;
      float* y = P.out + (size_t)row * 1024;
      s[rr] = 0.f;
#pragma unroll
      for (int i = 0; i < 4; ++i) s[rr] += (v[rr][i][0] + v[rr][i][1]) + (v[rr][i][2] + v[rr][i][3]);
#pragma unroll
      for (int o = 1; o < 64; o <<= 1) s[rr] += __shfl_xor(s[rr], o);
      const float mu = s[rr] * (1.f / 1024.f); q[rr] = 0.f;
#pragma unroll
      for (int i = 0; i < 4; ++i) { v[rr][i] = v[rr][i] - mu; q[rr] += (v[rr][i][0] * v[rr][i][0] + v[rr][i][1] * v[rr][i][1]) + (v[rr][i][2] * v[rr][i][2] + v[rr][i][3] * v[rr][i][3]); }
#pragma unroll
      for (int o = 1; o < 64; o <<= 1) q[rr] += __shfl_xor(q[rr], o);
      const float rstd = rsqrtf(q[rr] * (1.f / 1024.f) + 1e-5f);
      const int cond = row < 8192 ? 0 : 1 + ((row - 8192) >> 12);
#pragma unroll
      for (int i = 0; i < 4; ++i) {
        const int col = i * 256 + lane * 4;
        const f32x4 o = v[rr][i] * rstd * *(const f32x4*)(g + col) + *(const f32x4*)(b + col);
        if (!dry) *(f32x4*)(y + col) = o;
        if (l == 0 && !dry) {
          const f32x4 h = o * (*(const f32x4*)(mod1 + cond * 3072 + 1024 + col) + 1.f) + *(const f32x4*)(mod1 + cond * 3072 + col);
          *(u32x2*)(WSP(bf16_t, OFF_H) + (size_t)row * 1024 + col) = pk4(h);
        }
      }
    }
  }
}

DI s16x8 scale8(s16x8 x, float sc) {
  const u32x4 u = __builtin_bit_cast(u32x4, x); u32x4 o;
  o.x = pk(bflo(u.x) * sc, bfhi(u.x) * sc); o.y = pk(bflo(u.y) * sc, bfhi(u.y) * sc); o.z = pk(bflo(u.z) * sc, bfhi(u.z) * sc); o.w = pk(bflo(u.w) * sc, bfhi(u.w) * sc);
  return __builtin_bit_cast(s16x8, o);
}
constexpr int LDV = 144;
constexpr int LDK = 80;
template <int MODE>
DI void attn_item(const Params& P, int l, const bf16_t* __restrict__ Qp  , int qstride,
                  const bf16_t* __restrict__ Kp  , int kstride, const bf16_t* __restrict__ VTp  , int T,
                  bf16_t* __restrict__ mixp  , unsigned char* smem, int dry = 0) {
  const int tid = otid(), lane = tid & 63, w = tid >> 6, r = lane & 15, quad = lane >> 4;
  constexpr int QW = MODE == 0 ? 32 : 16;
  const float sl2 = (MODE == 0 ? 0.125f : 0.17677669529663687f) * 1.4426950408889634f;
  s16x8 qf[2][2];
  if (MODE == 0) {
#pragma unroll
    for (int qt = 0; qt < 2; ++qt)
#pragma unroll
      for (int ks = 0; ks < 2; ++ks) qf[qt][ks] = scale8(*(const s16x8*)(Qp + (size_t)(w * QW + qt * 16 + r) * qstride + 32 * ks + 8 * quad), sl2);
  } else {
#pragma unroll
    for (int ks = 0; ks < 2; ++ks) { qf[0][ks] = scale8(*(const s16x8*)(Qp + (size_t)(w * QW + r) * qstride + 32 * ks + 8 * quad), sl2); qf[1][ks] = qf[0][ks]; }
  }
  float mref[2] = {0.f, 0.f};
  f32x4 lsT[2] = {{0.f, 0.f, 0.f, 0.f}, {0.f, 0.f, 0.f, 0.f}};
  const s16x8 ones = {0x3F80, 0x3F80, 0x3F80, 0x3F80, 0x3F80, 0x3F80, 0x3F80, 0x3F80};
  f32x4 oT[2][4];
#pragma unroll
  for (int p = 0; p < 2; ++p)
#pragma unroll
    for (int mt = 0; mt < 4; ++mt) oT[p][mt] = (f32x4){0.f, 0.f, 0.f, 0.f};
  unsigned char* Kb0 = smem;
  bf16_t* Vs0 = (bf16_t*)(smem + 32768);
  const int srow = tid >> 3, skc = ((tid & 7) ^ (srow & 7)) * 8;
  const int vrow = tid >> 4, vc8 = (tid & 15) * 8;
  const int vm = (tid & 3), vg = (vc8 & ~31);
  const int vp0 = vg + 8 * ((2 * vm) & 3) + 4 * (vm >> 1), vp1 = vg + 8 * ((2 * vm + 1) & 3) + 4 * (vm >> 1);
  u32x4 rv[2];
  const int nstage = T / 128;
#define AK_DMA(st_, buf_) do { LAS unsigned char* lb_ = (LAS unsigned char*)smem + (buf_) * 16384 + w * 1024; _Pragma("unroll") for (int i = 0; i < 2; ++i) \
    __builtin_amdgcn_global_load_lds((const unsigned*)(Kp + (size_t)((st_) * 128 + 64 * i + srow) * kstride + skc), (LAS unsigned*)(lb_ + i * 8192), 16, 0, 0); } while (0)
  __syncthreads();
  AK_DMA(0, 0);
#pragma unroll
  for (int i = 0; i < 2; ++i) rv[i] = *(const u32x4*)(VTp + (size_t)(32 * i + vrow) * T + vc8);
#pragma unroll
  for (int i = 0; i < 2; ++i) { *(u32x2*)(Vs0 + (32 * i + vrow) * LDV + vp0) = (u32x2){rv[i].x, rv[i].y}; *(u32x2*)(Vs0 + (32 * i + vrow) * LDV + vp1) = (u32x2){rv[i].z, rv[i].w}; }
  asm volatile("s_waitcnt vmcnt(0)" ::: "memory");
  __syncthreads();
  for (int st = 0; st < nstage; ++st) {
    if (st + 1 < nstage) {
      AK_DMA(st + 1, (st + 1) & 1);
      const int key0 = (st + 1) * 128;
#pragma unroll
      for (int i = 0; i < 2; ++i) rv[i] = *(const u32x4*)(VTp + (size_t)(32 * i + vrow) * T + key0 + vc8);
    }
    f32x4 sT[2][2][4];
#pragma unroll
    for (int hk = 0; hk < 2; ++hk) {
      const unsigned char* Ks = Kb0 + (st & 1) * 16384 + hk * 8192;
      s16x8 kf[4][2];
#pragma unroll
      for (int mt = 0; mt < 4; ++mt)
#pragma unroll
        for (int ks = 0; ks < 2; ++ks) kf[mt][ks] = *(const s16x8*)(Ks + (16 * mt + r) * 128 + (((4 * ks + quad) ^ (r & 7)) * 16));
      const f32x4 z0 = {-mref[0], -mref[0], -mref[0], -mref[0]}, z1 = {-mref[1], -mref[1], -mref[1], -mref[1]};
      if (MODE == 0) {
#pragma unroll
        for (int mt = 0; mt < 4; ++mt) { sT[hk][0][mt] = MFMA(kf[mt][0], qf[0][0], z0); sT[hk][1][mt] = MFMA(kf[mt][0], qf[1][0], z1); }
#pragma unroll
        for (int mt = 0; mt < 4; ++mt) { sT[hk][0][mt] = MFMA(kf[mt][1], qf[0][1], sT[hk][0][mt]); sT[hk][1][mt] = MFMA(kf[mt][1], qf[1][1], sT[hk][1][mt]); }
      } else {
#pragma unroll
        for (int mt = 0; mt < 4; ++mt) { sT[hk][0][mt] = MFMA(kf[mt][0], qf[0][0], z0); sT[hk][1][mt] = MFMA(kf[mt][1], qf[0][1], z1); }
      }
    }
#pragma unroll
   for (int hk = 0; hk < 2; ++hk) {
    const int kt = 2 * st + hk;
    const bf16_t* Vs = Vs0 + (st & 1) * 64 * LDV + hk * 64;
    s16x8 vf[4][2];
#pragma unroll
    for (int mt = 0; mt < 4; ++mt)
#pragma unroll
      for (int k2 = 0; k2 < 2; ++k2) {
        vf[mt][k2] = *(const s16x8*)(Vs + (16 * mt + r) * LDV + 32 * k2 + 8 * quad);
      }
    __builtin_amdgcn_sched_barrier(0);
    s16x8 pb[2][2];
#pragma unroll
    for (int p = 0; p < 2; ++p) {
      f32x4 pv[4];
      bool redo = (kt == 0);
      for (;;) {
        if (redo) {
          float mx = -1e30f;
#pragma unroll
          for (int mt = 0; mt < 4; ++mt)
#pragma unroll
            for (int j = 0; j < 4; ++j) mx = fmaxf(mx, sT[hk][p][mt][j]);
          mx = fmaxf(mx, __shfl_xor(mx, 16)); mx = fmaxf(mx, __shfl_xor(mx, 32));
          const float alpha = kt == 0 ? 0.f : __builtin_amdgcn_exp2f(-mx);
          mref[p] += mx; lsT[p] = lsT[p] * alpha;
#pragma unroll
          for (int mt = 0; mt < 4; ++mt) { oT[p][mt] = oT[p][mt] * alpha; sT[hk][p][mt] = sT[hk][p][mt] - mx; }
          if (hk == 0) {
#pragma unroll
            for (int mt = 0; mt < 4; ++mt) sT[1][p][mt] = sT[1][p][mt] - mx;
          }
        }
        if (!redo) {
          float mg = -1e30f;
#pragma unroll
          for (int mt = 0; mt < 4; ++mt)
#pragma unroll
            for (int j = 0; j < 4; ++j) mg = fmaxf(mg, sT[hk][p][mt][j]);
          if (__builtin_amdgcn_ballot_w64(!(mg < 20.f)) != 0ull) { redo = true; continue; }
        }
#pragma unroll
        for (int mt = 0; mt < 4; ++mt)
#pragma unroll
          for (int j = 0; j < 4; ++j) pv[mt][j] = __builtin_amdgcn_exp2f(sT[hk][p][mt][j]);
        break;
      }
#pragma unroll
      for (int k2 = 0; k2 < 2; ++k2) {
        u32x4 u; u.x = pk(pv[2 * k2][0], pv[2 * k2][1]); u.y = pk(pv[2 * k2][2], pv[2 * k2][3]);
        u.z = pk(pv[2 * k2 + 1][0], pv[2 * k2 + 1][1]); u.w = pk(pv[2 * k2 + 1][2], pv[2 * k2 + 1][3]);
        pb[p][k2] = __builtin_bit_cast(s16x8, u);
      }
    }
#pragma unroll
    for (int mt = 0; mt < 4; ++mt)
#pragma unroll
      for (int k2 = 0; k2 < 2; ++k2) {
        oT[0][mt] = MFMA(vf[mt][k2], pb[0][k2], oT[0][mt]);
        oT[1][mt] = MFMA(vf[mt][k2], pb[1][k2], oT[1][mt]);
      }
#pragma unroll
    for (int k2 = 0; k2 < 2; ++k2) { lsT[0] = MFMA(ones, pb[0][k2], lsT[0]); lsT[1] = MFMA(ones, pb[1][k2], lsT[1]); }
   }
    if (st + 1 < nstage) {
      bf16_t* Vd = Vs0 + ((st + 1) & 1) * 64 * LDV;
#pragma unroll
      for (int i = 0; i < 2; ++i) { *(u32x2*)(Vd + (32 * i + vrow) * LDV + vp0) = (u32x2){rv[i].x, rv[i].y}; *(u32x2*)(Vd + (32 * i + vrow) * LDV + vp1) = (u32x2){rv[i].z, rv[i].w}; }
    }
    asm volatile("s_waitcnt vmcnt(0)" ::: "memory");
    __syncthreads();
  }
#undef AK_DMA
  float inv[2];
#pragma unroll
  for (int p = 0; p < 2; ++p) inv[p] = 1.f / lsT[p][0];
  if (dry) return;
  if (MODE == 0) {
#pragma unroll
    for (int qt = 0; qt < 2; ++qt) {
      bf16_t* dst = mixp + (size_t)(w * QW + qt * 16 + r) * 1024 + 4 * quad;
#pragma unroll
      for (int mt = 0; mt < 4; ++mt) {
        const f32x4 g = unpk4(*(const u32x2*)(dst + 16 * mt));
        *(u32x2*)(dst + 16 * mt) = pk4(oT[qt][mt] * inv[qt] * g);
      }
    }
  } else {
    const float lam = WSP(float, OFF_LAM)[l];
    const float li = 0.8f - 0.6f * expf(-0.3f * (float)l);
    f32x4 o[4]; float ss = 0.f;
#pragma unroll
    for (int mt = 0; mt < 4; ++mt) { o[mt] = oT[0][mt] * inv[0] - oT[1][mt] * (inv[1] * lam); ss += (o[mt][0] * o[mt][0] + o[mt][1] * o[mt][1]) + (o[mt][2] * o[mt][2] + o[mt][3] * o[mt][3]); }
    ss += __shfl_xor(ss, 16); ss += __shfl_xor(ss, 32);
    const float rinv = rsqrtf(ss * (1.f / 64.f) + 1e-6f) * (1.f - li);
    bf16_t* dst = mixp + (size_t)(w * QW + r) * 1024 + 4 * quad;
#pragma unroll
    for (int mt = 0; mt < 4; ++mt) {
      const f32x4 g = unpk4(*(const u32x2*)(dst + 16 * mt));
      const f32x4 sub = *(const f32x4*)(P.dsub + l * 64 + 16 * mt + 4 * quad);
      *(u32x2*)(dst + 16 * mt) = pk4(o[mt] * rinv * sub * g);
    }
  }
}

DI void mm64(const bf16_t* A, const bf16_t* Bt, int w, int lane, f32x4 (&acc)[4]) {
  const int r = lane & 15, quad = lane >> 4;
#pragma unroll
  for (int ks = 0; ks < 2; ++ks) {
    const s16x8 a = *(const s16x8*)(A + (16 * w + r) * LD + 32 * ks + 8 * quad);
#pragma unroll
    for (int nt = 0; nt < 4; ++nt) { const s16x8 b = *(const s16x8*)(Bt + (16 * nt + r) * LD + 32 * ks + 8 * quad); acc[nt] = MFMA(a, b, acc[nt]); }
  }
}

DI void hgrn_gload(const float* __restrict__ garr, int tok0, int h, int dir, float (&gv)[16]) {
  const int tid = otid() & 255, kk = tid & 63, q4 = tid >> 6;
#pragma unroll
  for (int i = 0; i < 16; ++i) { const int t = 16 * q4 + i, token = dir ? tok0 + 63 - t : tok0 + t; gv[i] = garr[(size_t)token * 256 + h * 64 + kk]; }
}
DI void hgrn_gates_pre(float* bt  , const float (&gv)[16], float (&dG)[16], float& glm, float& Mv) {
  const int tid = otid() & 255, kk = tid & 63, q4 = tid >> 6;
  float run = 0.f;
#pragma unroll
  for (int i = 0; i < 16; ++i) { run += gv[i]; dG[i] = run; }
  bt[q4 * 64 + kk] = run;
  __syncthreads();
  const float b0 = bt[kk], b1 = bt[64 + kk], b2 = bt[128 + kk], b3 = bt[192 + kk];
  const float R = q4 == 0 ? 0.f : (q4 == 1 ? b0 : (q4 == 2 ? b0 + b1 : b0 + b1 + b2));
  Mv = b0 + b1; glm = b2 + b3;
#pragma unroll
  for (int i = 0; i < 16; ++i) dG[i] = R + dG[i] - Mv;
}
DI void hgrn_gates(const float* __restrict__ garr, int tok0, int h, int dir, float* bt, float (&gv)[16], float (&dG)[16], float& glm, float& Mv) {
  hgrn_gload(garr, tok0, h, dir, gv);
  hgrn_gates_pre(bt, gv, dG, glm, Mv);
}

DI void hgrn_a_item(const Params& P, int pair, unsigned char* smem0) {
  const int tid0 = otid(), tid = tid0 & 255, lane = tid & 63, w = tid >> 6, kk = tid & 63, q4 = tid >> 6;
  const int it = 2 * pair + (tid0 >> 8); unsigned char* smem = smem0 + (tid0 >> 8) * HALF_LDS;
  const int dir = it & 1, h = (it >> 1) & 3, tc = it >> 3, tok0 = tc * 64;
  bf16_t* KT = (bf16_t*)smem; bf16_t* VT = KT + 64 * LD; float* bt = (float*)(smem + 40960); float* scl = bt + 256;
  __syncthreads();
  float gv[16], dG[16], glm, Mv;
  float vv[16];
  {
    const bf16_t* hv = WSP(bf16_t, OFF_HV);
#pragma unroll
    for (int i = 0; i < 16; ++i) { const int t = 16 * q4 + i, token = dir ? tok0 + 63 - t : tok0 + t; vv[i] = bf2f(hv[(size_t)token * 256 + h * 64 + kk]); }
  }
  hgrn_gates(WSP(float, dir ? OFF_GB : OFF_GF), tok0, h, dir, bt, gv, dG, glm, Mv);
  {
    u32x4 u0, u1; float kh[16];
#pragma unroll
    for (int i = 0; i < 16; ++i) kh[i] = (1.f - __expf(gv[i])) * __expf(fminf(-dG[i], 80.f));
    u0.x = pk(kh[0], kh[1]); u0.y = pk(kh[2], kh[3]); u0.z = pk(kh[4], kh[5]); u0.w = pk(kh[6], kh[7]);
    u1.x = pk(kh[8], kh[9]); u1.y = pk(kh[10], kh[11]); u1.z = pk(kh[12], kh[13]); u1.w = pk(kh[14], kh[15]);
    *(u32x4*)(KT + kk * LD + 16 * q4) = u0; *(u32x4*)(KT + kk * LD + 16 * q4 + 8) = u1;
    if (q4 == 0) { scl[kk] = __expf(glm); WSP(float, OFF_HP)[(size_t)it * 64 + kk] = __expf(glm + Mv); }
    u0.x = pk(vv[0], vv[1]); u0.y = pk(vv[2], vv[3]); u0.z = pk(vv[4], vv[5]); u0.w = pk(vv[6], vv[7]);
    u1.x = pk(vv[8], vv[9]); u1.y = pk(vv[10], vv[11]); u1.z = pk(vv[12], vv[13]); u1.w = pk(vv[14], vv[15]);
    *(u32x4*)(VT + kk * LD + 16 * q4) = u0; *(u32x4*)(VT + kk * LD + 16 * q4 + 8) = u1;
  }
  __syncthreads();
  f32x4 acc[4];
#pragma unroll
  for (int nt = 0; nt < 4; ++nt) acc[nt] = (f32x4){0.f, 0.f, 0.f, 0.f};
  mm64(KT, VT, w, lane, acc);
  float* U = WSP(float, OFF_HS) + (size_t)it * 4096;
  const int c = lane & 15, quad = lane >> 4;
#pragma unroll
  for (int j = 0; j < 4; ++j) {
    const int k = 16 * w + 4 * quad + j; const float s = scl[k];
#pragma unroll
    for (int nt = 0; nt < 4; ++nt) U[k * 64 + 16 * nt + c] = acc[nt][j] * s;
  }
}

DI void hgrn_b_item(const Params& P, int l, int it, unsigned char* smem) {
  const int tid = otid(), g = tid >> 6, e = tid & 63;
  const int sq = it >> 6, b = sq >> 3, h = (sq >> 1) & 3, dir = sq & 1, eg = it & 63, kv = eg * 64 + e, c0 = 128 + b * 64;
  float* HS = WSP(float, OFF_HS); const float* HP = WSP(float, OFF_HP);
  float* gp = (float*)smem; float* gu = gp + 512;
  float U[8], Pd[8];
#pragma unroll
  for (int u = 0; u < 8; ++u) { const int ci = 8 * g + u, tc = dir ? c0 + 63 - ci : c0 + ci; const size_t idx = (size_t)(tc * 4 + h) * 2 + dir; U[u] = HS[idx * 4096 + kv]; Pd[u] = HP[idx * 64 + eg]; }
  float S = P.st[((size_t)((b * 2 + l) * 2 + dir) * 4 + h) * 4096 + kv];
  float Pg = 1.f, Ug = 0.f;
#pragma unroll
  for (int u = 0; u < 8; ++u) { Ug = Pd[u] * Ug + U[u]; Pg *= Pd[u]; }
  __syncthreads();
  gp[g * 64 + e] = Pg; gu[g * 64 + e] = Ug;
  __syncthreads();
  for (int gg = 0; gg < g; ++gg) S = gp[gg * 64 + e] * S + gu[gg * 64 + e];
#pragma unroll
  for (int u = 0; u < 8; ++u) { const int ci = 8 * g + u, tc = dir ? c0 + 63 - ci : c0 + ci; const size_t idx = (size_t)(tc * 4 + h) * 2 + dir; HS[idx * 4096 + kv] = S; S = Pd[u] * S + U[u]; }
}

DI void hgrn_c_item(const Params& P, int l, int pair, unsigned char* smem0, int dry = 0) {
  const int tid0 = otid(), tid = tid0 & 255, lane = tid & 63, w = tid >> 6, kk = tid & 63, q4 = tid >> 6, c = lane & 15, quad = lane >> 4;
  const int it = 2 * pair + (tid0 >> 8); unsigned char* smem = smem0 + (tid0 >> 8) * HALF_LDS;
  const int h = it & 3, tc = it >> 2, tok0 = tc * 64;
  bf16_t* QH = (bf16_t*)smem; bf16_t* KH = QH + 64 * LD; bf16_t* VT = KH + 64 * LD; bf16_t* ST = VT + 64 * LD; bf16_t* AM = KH;
  float* bt = (float*)(smem + 40960); float* em = bt + 256;
  f32x4 ob[4], of[4];
  float qvN[16], vvN[16], gvN[16];
#pragma unroll
  for (int dd = 0; dd < 2; ++dd) {
    const int dir = 1 - dd;
    const size_t idx = (size_t)(tc * 4 + h) * 2 + dir;
    __syncthreads();
    const float* HSb = WSP(float, OFF_HS); const float* HPb = WSP(float, OFF_HP);
    const float* Sp = HSb + idx * 4096;
    const int cq = tc & ~3, pos = dir ? cq + 3 - tc : tc - cq;
    const int kb = tid >> 6, vv0 = tid & 63;
    float sv[16], qv[16], vv[16], gv[16];
    if (dd == 0) {
      const bf16_t* hq = WSP(bf16_t, OFF_HQ); const bf16_t* hv = WSP(bf16_t, OFF_HV);
#pragma unroll
      for (int i = 0; i < 16; ++i) {
        const int t = 16 * q4 + i, token = tok0 + 63 - t;
        qv[i] = bf2f(hq[(size_t)token * 256 + h * 64 + kk]); vv[i] = bf2f(hv[(size_t)token * 256 + h * 64 + kk]);
      }
      hgrn_gload(WSP(float, OFF_GB), tok0, h, 1, gv);
#pragma unroll
      for (int i = 0; i < 16; ++i) {
        const int token = tok0 + 16 * q4 + i;
        qvN[i] = bf2f(hq[(size_t)token * 256 + h * 64 + kk]); vvN[i] = bf2f(hv[(size_t)token * 256 + h * 64 + kk]);
      }
      hgrn_gload(WSP(float, OFF_GF), tok0, h, 0, gvN);
    } else {
#pragma unroll
      for (int i = 0; i < 16; ++i) { qv[i] = qvN[i]; vv[i] = vvN[i]; gv[i] = gvN[i]; }
    }
    if (tc >= 128) {
#pragma unroll
      for (int e = 0; e < 16; ++e) sv[e] = Sp[tid + 256 * e];
    } else {
#pragma unroll
      for (int e = 0; e < 16; ++e) sv[e] = 0.f;
      for (int ci = 0; ci < pos; ++ci) {
        const int tcp = dir ? cq + 3 - ci : cq + ci; const size_t ip = (size_t)(tcp * 4 + h) * 2 + dir;
        float uu[16], pp[16];
#pragma unroll
        for (int e = 0; e < 16; ++e) { uu[e] = HSb[ip * 4096 + tid + 256 * e]; pp[e] = HPb[ip * 64 + kb + 4 * e]; }
#pragma unroll
        for (int e = 0; e < 16; ++e) sv[e] = pp[e] * sv[e] + uu[e];
      }
      if (pos == 3 && !dry) {
        float* op = P.out + OUT_ST + ((size_t)(((tc >> 2) * 2 + l) * 2 + dir) * 4 + h) * 4096;
#pragma unroll
        for (int e = 0; e < 16; ++e) op[tid + 256 * e] = HPb[idx * 64 + kb + 4 * e] * sv[e] + Sp[tid + 256 * e];
      }
    }
    float dG[16], glm, Mv;
    hgrn_gates_pre(bt, gv, dG, glm, Mv);
    {
#pragma unroll
      for (int i = 0; i < 16; ++i) {
        const int t = 16 * q4 + i;
        QH[t * LD + kk] = f2bf(qv[i] * __expf(fminf(dG[i], 80.f)));
        KH[t * LD + kk] = f2bf((1.f - __expf(gv[i])) * __expf(fminf(-dG[i], 80.f)));
      }
      u32x4 u0, u1;
      u0.x = pk(vv[0], vv[1]); u0.y = pk(vv[2], vv[3]); u0.z = pk(vv[4], vv[5]); u0.w = pk(vv[6], vv[7]);
      u1.x = pk(vv[8], vv[9]); u1.y = pk(vv[10], vv[11]); u1.z = pk(vv[12], vv[13]); u1.w = pk(vv[14], vv[15]);
      *(u32x4*)(VT + kk * LD + 16 * q4) = u0; *(u32x4*)(VT + kk * LD + 16 * q4 + 8) = u1;
      const float emk = __expf(Mv);
      if (q4 == 0) em[kk] = emk;
    }
    __syncthreads();
#pragma unroll
    for (int e = 0; e < 16; ++e) ST[vv0 * LD + kb + 4 * e] = f2bf(sv[e] * em[kb + 4 * e]);
    __syncthreads();
    f32x4 aa[4];
#pragma unroll
    for (int nt = 0; nt < 4; ++nt) aa[nt] = (f32x4){0.f, 0.f, 0.f, 0.f};
    mm64(QH, KH, w, lane, aa);
    __syncthreads();
#pragma unroll
    for (int j = 0; j < 4; ++j) {
      const int t = 16 * w + 4 * quad + j;
#pragma unroll
      for (int nt = 0; nt < 4; ++nt) { const int s = 16 * nt + c; AM[t * LD + s] = f2bf(s <= t ? aa[nt][j] : 0.f); }
    }
    __syncthreads();
    f32x4 acc[4];
#pragma unroll
    for (int nt = 0; nt < 4; ++nt) acc[nt] = (f32x4){0.f, 0.f, 0.f, 0.f};
    mm64(AM, VT, w, lane, acc);
    mm64(QH, ST, w, lane, acc);
    if (dd == 0) {
#pragma unroll
      for (int nt = 0; nt < 4; ++nt) ob[nt] = acc[nt];
    } else {
#pragma unroll
      for (int nt = 0; nt < 4; ++nt) of[nt] = acc[nt];
    }
  }
  __syncthreads();
  float* OB = (float*)smem;
#pragma unroll
  for (int j = 0; j < 4; ++j)
#pragma unroll
    for (int nt = 0; nt < 4; ++nt) OB[(16 * w + 4 * quad + j) * 64 + 16 * nt + c] = ob[nt][j];
  __syncthreads();
  bf16_t* mix = WSP(bf16_t, OFF_MIX);
#pragma unroll
  for (int j = 0; j < 4; ++j) {
    const int t = 16 * w + 4 * quad + j;
    float o[4], ss = 0.f;
#pragma unroll
    for (int nt = 0; nt < 4; ++nt) { o[nt] = of[nt][j] + OB[(63 - t) * 64 + 16 * nt + c]; ss += o[nt] * o[nt]; }
    ss += __shfl_xor(ss, 1); ss += __shfl_xor(ss, 2); ss += __shfl_xor(ss, 4); ss += __shfl_xor(ss, 8);
    const float rinv = rsqrtf(ss * (1.f / 64.f) + 1e-6f);
    bf16_t* dst = mix + (size_t)(tok0 + t) * 1024 + 768 + h * 64 + c;
    if (!dry)
#pragma unroll
    for (int nt = 0; nt < 4; ++nt) dst[16 * nt] = f2bf(o[nt] * rinv * P.hnorm[l * 64 + 16 * nt + c] * bf2f(dst[16 * nt]));
  }
}

DI void phase_mixers(const Params& P, int l, unsigned char* smem, int dry = 0) {
  const int xcd = blockIdx.x & 7, nbx = gridDim.x >> 3;
  for (int j = blockIdx.x >> 3; j < 64; j += nbx) {
    const int b = xcd >> 2;
    if (j < 32) {
      const int hq = 2 * (xcd & 3) + (j >> 4), qb = j & 15, kvh = hq >> 2;
      const int tokq = 8192 + b * 4096 + qb * 256;
      attn_item<0>(P, l, WSP(bf16_t, OFF_QA) + (size_t)tokq * 512 + hq * 64, 512,
                   WSP(bf16_t, OFF_KA_LAT) + (size_t)(l * 2 + b) * 4352 * 128 + kvh * 64, 128,
                   WSP(bf16_t, OFF_VTA_LAT) + ((size_t)(l * 2 + b) * 2 + kvh) * 64 * 4352, 4352,
                   WSP(bf16_t, OFF_MIX) + (size_t)tokq * 1024 + hq * 64, smem, dry);
    } else {
      const int h = xcd & 3, qb = j - 32;
      const int tokq = 8192 + b * 4096 + qb * 128;
      attn_item<1>(P, l, WSP(bf16_t, OFF_QD) + (size_t)tokq * 256 + h * 64, 256,
                   WSP(bf16_t, OFF_KD_LAT) + (size_t)(l * 2 + b) * 4352 * 256 + h * 64, 256,
                   WSP(bf16_t, OFF_VTD_LAT) + ((size_t)(l * 2 + b) * 4 + h) * 64 * 4352, 4352,
                   WSP(bf16_t, OFF_MIX) + (size_t)tokq * 1024 + 512 + h * 64, smem, dry);
    }
  }
  for (int it = blockIdx.x; it < 1536; it += gridDim.x) {
    if (it < 256) {
      const int b = it >> 3, hq = it & 7, kvh = hq >> 2;
      const int tokq = b * 256;
      attn_item<0>(P, l, WSP(bf16_t, OFF_QA) + (size_t)tokq * 512 + hq * 64, 512,
                   WSP(bf16_t, OFF_KA_CTX) + (size_t)b * 256 * 128 + kvh * 64, 128,
                   WSP(bf16_t, OFF_VTA_CTX) + (size_t)(b * 2 + kvh) * 64 * 256, 256,
                   WSP(bf16_t, OFF_MIX) + (size_t)tokq * 1024 + hq * 64, smem, dry);
    } else if (it < 512) {
      const int i2 = it - 256, b = i2 >> 3, h = (i2 >> 1) & 3, qb = i2 & 1;
      const int tokq = b * 256 + qb * 128;
      attn_item<1>(P, l, WSP(bf16_t, OFF_QD) + (size_t)tokq * 256 + h * 64, 256,
                   WSP(bf16_t, OFF_KD_CTX) + (size_t)b * 256 * 256 + h * 64, 256,
                   WSP(bf16_t, OFF_VTD_CTX) + (size_t)(b * 4 + h) * 64 * 256, 256,
                   WSP(bf16_t, OFF_MIX) + (size_t)tokq * 1024 + 512 + h * 64, smem, dry);
    } else hgrn_a_item(P, it - 512, smem);
  }
}

__global__ void __launch_bounds__(NT, 2) fwd_megakernel(Params P) {
  cg::grid_group grid = cg::this_grid();
  extern __shared__ __attribute__((aligned(16))) unsigned char smem[];
  __shared__ uint4 xb_words;
  if (threadIdx.x == 0) xb_words = make_uint4(0u, 0u, 0u, 0u);
  __syncthreads();
  const XcdBarrier xb = xcd_barrier_post(WSP(unsigned, OFF_BAR), (volatile LAS unsigned*)&xb_words);
  if (P.out == nullptr) grid.sync();
#define GSYNC() xcd_barrier(xb)
  for (int it = blockIdx.x; it < P0_ITEMS; it += gridDim.x) p0_item(P, it, smem);
  GSYNC();
  p0b(P);
  GSYNC();
#pragma unroll 1
  for (int l = 0; l < 2; ++l) {
    phase_inproj(P, l, smem);
    GSYNC();
    phase_mixers(P, l, smem);
    GSYNC();
    for (int it = blockIdx.x; it < 1024; it += gridDim.x) hgrn_b_item(P, l, it, smem);
    GSYNC();
    for (int it = blockIdx.x; it < 512; it += gridDim.x) hgrn_c_item(P, l, it, smem);
    GSYNC();
    phase_outproj(P, l, smem);
    GSYNC();
    phase_ln(P, l);
    if (l == 0) GSYNC();
  }
}

extern "C" void kernel_launch(void* const* d_in, const int* in_sizes, int n_in, void* d_out, int out_size,
                              void* d_ws, size_t ws_size, hipStream_t stream) {
  static int grid_blocks = 0;
  if (!grid_blocks) {
    int dev = 0, cus = 0, per_cu = 0;
    (void)hipGetDevice(&dev);
    (void)hipDeviceGetAttribute(&cus, hipDeviceAttributeMultiprocessorCount, dev);
    if (hipFuncSetAttribute((const void*)fwd_megakernel, hipFuncAttributeMaxDynamicSharedMemorySize, SMEM_BYTES) != hipSuccess) fprintf(stderr, "hipFuncSetAttribute failed\n");
    (void)hipOccupancyMaxActiveBlocksPerMultiprocessor(&per_cu, (const void*)fwd_megakernel, NT, SMEM_BYTES);
    if (per_cu < 1) per_cu = 1;
    if (per_cu > 1) per_cu = 1;
    grid_blocks = cus * per_cu;
  }
  if (ws_size < WS_END) { fprintf(stderr, "workspace too small: %zu < %zu\n", ws_size, (size_t)WS_END); return; }
  Params p{};
  const float* const* in = (const float* const*)d_in;
  p.xp = in[0]; p.xs = in[1]; p.cgk = in[2]; p.cgv = in[3]; p.cdk = in[4]; p.cdv = in[5]; p.st = in[6]; p.c = in[7]; p.cctx = in[8];
  p.wada = in[9]; p.bada = in[10]; p.win = in[11]; p.qn = in[12]; p.kn = in[13]; p.dlam = in[14]; p.dsub = in[15]; p.hlb = in[16]; p.hnorm = in[17];
  p.wout = in[18]; p.lng = in[19]; p.lnb = in[20];
  p.out = (float*)d_out; p.ws = (unsigned char*)d_ws;
  (void)hipMemsetAsync((unsigned char*)d_ws + OFF_MOD, 0, 73728, stream);
  (void)hipMemsetAsync((unsigned char*)d_ws + OFF_BAR, 0, XCD_BAR_WORDS * 4, stream);
  void* args[] = {&p};
  hipError_t e = hipLaunchCooperativeKernel((void*)fwd_megakernel, dim3(grid_blocks), dim3(NT), args, SMEM_BYTES, stream);
  if (e != hipSuccess) fprintf(stderr, "cooperative launch failed: %s (grid %d)\n", hipGetErrorString(e), grid_blocks);
}
```

```cpp
#include <hip/hip_runtime.h>
#include <hip/hip_cooperative_groups.h>
#include <cstdio>
#include <cstdint>
namespace cg = cooperative_groups;
#define DI __device__ __forceinline__
typedef unsigned short bf16_t;
typedef short s16x8 __attribute__((ext_vector_type(8)));
typedef short s16x4 __attribute__((ext_vector_type(4)));
typedef float f32x4 __attribute__((ext_vector_type(4)));
typedef float f32x2 __attribute__((ext_vector_type(2)));
typedef unsigned u32x4 __attribute__((ext_vector_type(4)));
typedef unsigned u32x2 __attribute__((ext_vector_type(2)));
typedef __bf16 bf2_t __attribute__((ext_vector_type(2)));
#define LAS __attribute__((address_space(3)))

struct Params {
  const float *xp, *xs, *cgk, *cgv, *cdk, *cdv, *st, *c, *cctx, *wada, *bada, *win, *qn, *kn, *dlam, *dsub, *hlb, *hnorm, *wout, *lng, *lnb;
  float* out; unsigned char* ws;
};

constexpr size_t OFF_MOD = 0;
constexpr size_t OFF_LBS = 73728;
constexpr size_t OFF_LAM = OFF_LBS + 4096;
constexpr size_t OFF_T64C = OFF_LAM + 256;
constexpr size_t OFF_T64S = OFF_T64C + 4096;
constexpr size_t OFF_T32C = OFF_T64S + 4096;
constexpr size_t OFF_T32S = OFF_T32C + 2048;
constexpr size_t OFF_BAR = 131072;
constexpr size_t OFF_WINT = 1u << 20;
constexpr size_t OFF_WOUTT = OFF_WINT + 14680064;
constexpr size_t OFF_H = OFF_WOUTT + 4194304;
constexpr size_t OFF_QA = OFF_H + 33554432;
constexpr size_t OFF_MIX = OFF_QA + 16777216;
constexpr size_t OFF_QD = OFF_MIX + 33554432;
constexpr size_t OFF_KA_CTX = OFF_QD + 8388608;
constexpr size_t OFF_VTA_CTX = OFF_KA_CTX + 2097152;
constexpr size_t OFF_KD_CTX = OFF_VTA_CTX + 2097152;
constexpr size_t OFF_VTD_CTX = OFF_KD_CTX + 4194304;
constexpr size_t OFF_KA_LAT = OFF_VTD_CTX + 4194304;
constexpr size_t OFF_VTA_LAT = OFF_KA_LAT + 4456448;
constexpr size_t OFF_KD_LAT = OFF_VTA_LAT + 4456448;
constexpr size_t OFF_VTD_LAT = OFF_KD_LAT + 8912896;
constexpr size_t OFF_HQ = OFF_VTD_LAT + 8912896;
constexpr size_t OFF_HV = OFF_HQ + 8388608;
constexpr size_t OFF_GF = OFF_HV + 8388608;
constexpr size_t OFF_GB = OFF_GF + 16777216;
constexpr size_t OFF_HS = OFF_GB + 16777216;
constexpr size_t OFF_HP = OFF_HS + 33554432;
constexpr size_t WS_END = OFF_HP + 524288;

constexpr size_t OUT_GK = 16777216, OUT_GV = 18874368, OUT_DK = 20971520, OUT_DV = 25165824, OUT_ST = 29360128;

constexpr int LD = 80;
constexpr int NT = 512;
constexpr int SMEM_BYTES = 131072;
constexpr int HALF_LDS = 43008;

DI unsigned pk(float a, float b) { f32x2 v = {a, b}; bf2_t r = __builtin_convertvector(v, bf2_t); return __builtin_bit_cast(unsigned, r); }
DI bf16_t f2bf(float a) { return (bf16_t)(pk(a, 0.f) & 0xffffu); }
DI float bf2f(bf16_t u) { return __uint_as_float((unsigned)u << 16); }
DI float bflo(unsigned u) { return __uint_as_float(u << 16); }
DI float bfhi(unsigned u) { return __uint_as_float(u & 0xffff0000u); }
DI u32x2 pk4(f32x4 v) { u32x2 r; r.x = pk(v[0], v[1]); r.y = pk(v[2], v[3]); return r; }
DI f32x4 unpk4(u32x2 u) { f32x4 r; r[0] = bflo(u.x); r[1] = bfhi(u.x); r[2] = bflo(u.y); r[3] = bfhi(u.y); return r; }
DI float siluf(float x) { return x * __builtin_amdgcn_rcpf(1.f + __expf(-x)); }
DI float sigmf(float x) { return __builtin_amdgcn_rcpf(1.f + __expf(-x)); }
DI f32x4 silu4(f32x4 v) { f32x4 r; for (int j = 0; j < 4; ++j) r[j] = siluf(v[j]); return r; }
#define MFMA(a, b, c) __builtin_amdgcn_mfma_f32_16x16x32_bf16((a), (b), (c), 0, 0, 0)
#define WSP(T, off) ((T*)(P.ws + (off)))
DI int otid() { int t = threadIdx.x; asm volatile("" : "+v"(t)); return t; }


#define XB_TMO      128
#define XB_XCNT(j)  (256  + 64 * (j))
#define XB_XSUB(j)  (1280 + 64 * (j))
#define XB_XGEN(j)  (2304 + 64 * (j))
#define XB_TOP      3328
#define XB_TOPGEN   3392
#define XCD_BAR_WORDS 3456
#define XB_SPIN_CAP (1u << 22)
DI unsigned xb_ld(unsigned* p)              { return __hip_atomic_load(p, __ATOMIC_RELAXED, __HIP_MEMORY_SCOPE_AGENT); }
DI unsigned xb_add(unsigned* p, unsigned v) { return __hip_atomic_fetch_add(p, v, __ATOMIC_RELAXED, __HIP_MEMORY_SCOPE_AGENT); }
DI unsigned xb_xcc_id() { return (unsigned)__builtin_amdgcn_s_getreg((3 << 11) | 20) & 0xFu; }
#define XB_SPIN(cond, bar) do { unsigned _sp = 0; while (cond) { __builtin_amdgcn_s_sleep(1); \
    if ((++_sp & 255u) == 0u) { if (xb_ld(&(bar)[XB_TMO])) break; if (_sp > XB_SPIN_CAP) { atomicAdd(&(bar)[XB_TMO], 1u); break; } } } } while (0)
struct XcdBarrier { unsigned* bar; unsigned x; volatile LAS unsigned* st; };
DI XcdBarrier xcd_barrier_post(unsigned* bar, volatile LAS unsigned* st) {
  XcdBarrier b; b.bar = bar; b.x = xb_xcc_id(); b.st = st;
  if (threadIdx.x == 0) (void)xb_add(&bar[XB_XCNT(b.x)], 1u);
  return b;
}
DI void xcd_barrier_complete(unsigned* bar, unsigned x, unsigned& nloc, unsigned& nx) {
  const unsigned G = gridDim.x * gridDim.y * gridDim.z;
  unsigned sum, cnt, mine, sp = 0u;
  for (;;) {
    sum = 0u; cnt = 0u; mine = 0u;
#pragma unroll
    for (unsigned j = 0; j < 16; ++j) { const unsigned c = xb_ld(&bar[XB_XCNT(j)]); sum += c; cnt += (c > 0u) ? 1u : 0u; mine = (j == x) ? c : mine; }
    if (sum == G) break;
    __builtin_amdgcn_s_sleep(1);
    if ((++sp & 255u) == 0u) { if (xb_ld(&bar[XB_TMO])) break; if (sp > XB_SPIN_CAP) { atomicAdd(&bar[XB_TMO], 1u); break; } }
  }
  nloc = mine > 0u ? mine : 1u; nx = cnt > 0u ? cnt : 1u;
}
DI void xcd_barrier(const XcdBarrier& b) {
  asm volatile("s_waitcnt vmcnt(0)" ::: "memory");
  __syncthreads();
  if (threadIdx.x == 0) {
    unsigned* bar = b.bar;
    __builtin_amdgcn_s_waitcnt(0);
    unsigned nloc = b.st[0], nx = b.st[1];
    if (nloc == 0u) { xcd_barrier_complete(bar, b.x, nloc, nx); b.st[0] = nloc; b.st[1] = nx; }
    const unsigned old = xb_add(&bar[XB_XSUB(b.x)], 1u);
    const unsigned gen = old / nloc;
    if (old + 1u == (gen + 1u) * nloc) {
      __builtin_amdgcn_fence(__ATOMIC_RELEASE, "agent");
      asm volatile("s_waitcnt vmcnt(0)" ::: "memory");
      const unsigned og = xb_add(&bar[XB_TOP], 1u);
      const unsigned tg = og / nx;
      if (og + 1u == (tg + 1u) * nx) xb_add(&bar[XB_TOPGEN], 1u);
      else XB_SPIN(xb_ld(&bar[XB_TOPGEN]) == tg, bar);
      __builtin_amdgcn_fence(__ATOMIC_ACQUIRE, "agent");
      xb_add(&bar[XB_XGEN(b.x)], 1u);
      asm volatile("s_waitcnt vmcnt(0)" ::: "memory");
    } else {
      XB_SPIN(xb_ld(&bar[XB_XGEN(b.x)]) == gen, bar);
      __builtin_amdgcn_fence(__ATOMIC_ACQUIRE, "agent");
      asm volatile("s_waitcnt vmcnt(0)" ::: "memory");
    }
  }
  __syncthreads();
}

constexpr int P0_ITEMS = 192 + 1152 + 192 + 1;
DI void p0_item(const Params& P, int it, unsigned char* smem) {
  const int tid = otid();
  if (it < 192) {
    const int l = it / 96, rem = it % 96, kc = rem / 6, cc = rem % 6;
    float* sil = (float*)smem;
    __syncthreads();
    if (tid < 192) { const int cnd = tid >> 6, kk = tid & 63, k = kc * 64 + kk; const float cv = cnd == 0 ? P.cctx[k] : P.c[(cnd - 1) * 1024 + k]; sil[tid] = siluf(cv); }
    __syncthreads();
    const int col = cc * NT + tid;
    const float* w = P.wada + ((size_t)l * 1024 + kc * 64) * 3072 + col;
    float a0 = 0.f, a1 = 0.f, a2 = 0.f;
#pragma unroll 8
    for (int kk = 0; kk < 64; ++kk) { const float wv = w[(size_t)kk * 3072]; a0 += sil[kk] * wv; a1 += sil[64 + kk] * wv; a2 += sil[128 + kk] * wv; }
    const float bb = kc == 0 ? P.bada[l * 3072 + col] : 0.f;
    float* mod = WSP(float, OFF_MOD) + (size_t)l * 9216 + col;
    atomicAdd(mod, a0 + bb); atomicAdd(mod + 3072, a1 + bb); atomicAdd(mod + 6144, a2 + bb);
    return;
  }
  it -= 192;
  if (it < 1152) {
    const int hb = tid >> 8, tl = tid & 255, it2 = 2 * it + hb;
    const float* src; bf16_t* dst; int N, tn, tk;
    if (it2 < 1792) { const int l = it2 / 896, r2 = it2 % 896; tn = r2 / 16; tk = r2 % 16; N = 3584; src = P.win + (size_t)l * 1024 * 3584; dst = WSP(bf16_t, OFF_WINT) + (size_t)l * 3584 * 1024; }
    else { const int i2 = it2 - 1792, l = i2 / 256, r2 = i2 % 256; tn = r2 / 16; tk = r2 % 16; N = 1024; src = P.wout + (size_t)l * 1024 * 1024; dst = WSP(bf16_t, OFF_WOUTT) + (size_t)l * 1024 * 1024; }
    float* tile = (float*)smem + hb * 4160;
    float rg[16];
#pragma unroll
    for (int u = 0; u < 16; ++u) { const int e = tl + 256 * u, kk = e >> 6, nn = e & 63; rg[u] = src[(size_t)(tk * 64 + kk) * N + tn * 64 + nn]; }
    __syncthreads();
#pragma unroll
    for (int u = 0; u < 16; ++u) { const int e = tl + 256 * u, kk = e >> 6, nn = e & 63; tile[kk * 65 + nn] = rg[u]; }
    __syncthreads();
#pragma unroll
    for (int u = 0; u < 8; ++u) { const int e = tl + 256 * u, nn = e >> 5, k2 = (e & 31) * 2;
      *(unsigned*)(dst + (size_t)(tn * 64 + nn) * 1024 + tk * 64 + k2) = pk(tile[k2 * 65 + nn], tile[(k2 + 1) * 65 + nn]); }
    return;
  }
  it -= 1152;
  if (it < 192) {
    for (int u = 0; u < 4096 / NT; ++u) {
      const int e = it * 4096 + u * NT + tid;
      if (e < 131072) {
        const int ci = e & 127, t = (e >> 7) & 255, b = (e >> 15) & 1, l = e >> 16;
        WSP(bf16_t, OFF_KA_LAT)[((size_t)(l * 2 + b) * 4352 + t) * 128 + ci] = f2bf(P.cgk[((size_t)(b * 2 + l) * 256 + t) * 128 + ci]);
      } else if (e < 262144) {
        const int e2 = e - 131072, t = e2 & 255, d = (e2 >> 8) & 63, kvh = (e2 >> 14) & 1, b = (e2 >> 15) & 1, l = e2 >> 16;
        WSP(bf16_t, OFF_VTA_LAT)[(((size_t)(l * 2 + b) * 2 + kvh) * 64 + d) * 4352 + t] = f2bf(P.cgv[((size_t)(b * 2 + l) * 256 + t) * 128 + kvh * 64 + d]);
      } else if (e < 524288) {
        const int e2 = e - 262144, ci = e2 & 255, t = (e2 >> 8) & 255, b = (e2 >> 16) & 1, l = e2 >> 17;
        WSP(bf16_t, OFF_KD_LAT)[((size_t)(l * 2 + b) * 4352 + t) * 256 + ci] = f2bf(P.cdk[((size_t)(b * 2 + l) * 256 + t) * 256 + ci]);
      } else {
        const int e2 = e - 524288, t = e2 & 255, d = (e2 >> 8) & 63, h = (e2 >> 14) & 3, b = (e2 >> 16) & 1, l = e2 >> 17;
        WSP(bf16_t, OFF_VTD_LAT)[(((size_t)(l * 2 + b) * 4 + h) * 64 + d) * 4352 + t] = f2bf(P.cdv[((size_t)(b * 2 + l) * 256 + t) * 256 + h * 64 + d]);
      }
    }
    return;
  }
  float* lbs = WSP(float, OFF_LBS);
  for (int e = tid; e < 512; e += NT) {
    const int dir = e >> 8, ci = e & 255;
    const float a0 = P.hlb[(0 * 2 + dir) * 256 + ci], a1 = P.hlb[(1 * 2 + dir) * 256 + ci], mx = fmaxf(a0, a1);
    const float e0 = expf(a0 - mx), e1 = expf(a1 - mx);
    lbs[(0 * 2 + dir) * 256 + ci] = 0.f; lbs[(1 * 2 + dir) * 256 + ci] = e1 / (e0 + e1);
  }
  if (tid < 2) {
    const int l = tid; float s1 = 0.f, s2 = 0.f;
    for (int i = 0; i < 32; ++i) { s1 += P.dlam[(l * 4 + 0) * 32 + i] * P.dlam[(l * 4 + 1) * 32 + i]; s2 += P.dlam[(l * 4 + 2) * 32 + i] * P.dlam[(l * 4 + 3) * 32 + i]; }
    const float li = 0.8f - 0.6f * expf(-0.3f * (float)l);
    WSP(float, OFF_LAM)[l] = expf(s1) - expf(s2) + li;
  }
  for (int e = tid; e < 1024; e += NT) { const int pos = e >> 4, i = e & 15; const float inv = powf(10000.f, -(float)i / 16.f), ang = (float)pos * inv; WSP(float, OFF_T64C)[e] = cosf(ang); WSP(float, OFF_T64S)[e] = sinf(ang); }
  for (int e = tid; e < 512; e += NT) { const int pos = e >> 3, i = e & 7; const float inv = powf(10000.f, -(float)i / 8.f), ang = (float)pos * inv; WSP(float, OFF_T32C)[e] = cosf(ang); WSP(float, OFF_T32S)[e] = sinf(ang); }
}

DI void p0b(const Params& P) {
  const int gtid = blockIdx.x * NT + threadIdx.x, gsz = gridDim.x * NT;
  const float* mod = WSP(float, OFF_MOD);
  bf16_t* H = WSP(bf16_t, OFF_H);
  for (int e = gtid; e < 16384 * 128; e += gsz) {
    const int token = e >> 7, c8 = (e & 127) * 8;
    const int cond = token < 8192 ? 0 : 1 + ((token - 8192) >> 12);
    const float* xr = (token < 8192 ? P.xp + (size_t)token * 1024 : P.xs + (size_t)(token - 8192) * 1024) + c8;
    const float* sh = mod + cond * 3072 + c8; const float* sc = sh + 1024;
    const f32x4 x0 = *(const f32x4*)xr, x1 = *(const f32x4*)(xr + 4);
    const f32x4 h0 = x0 * (*(const f32x4*)sc + 1.f) + *(const f32x4*)sh, h1 = x1 * (*(const f32x4*)(sc + 4) + 1.f) + *(const f32x4*)(sh + 4);
    u32x4 o; o.x = pk(h0[0], h0[1]); o.y = pk(h0[2], h0[3]); o.z = pk(h1[0], h1[1]); o.w = pk(h1[2], h1[3]);
    *(u32x4*)(H + (size_t)token * 1024 + c8) = o;
  }
}

template <int MT>
DI void gemm_tile(const bf16_t* __restrict__ A, const bf16_t* __restrict__ Bt, int K, int row0, int col0, unsigned char* smem, f32x4 (&acc)[MT][4]) {
  const int tid = otid(), lane = tid & 63, w = tid >> 6, wm = w >> 2, wn = w & 3, r = lane & 15, quad = lane >> 4;
  const bf16_t* Ag = A + (size_t)row0 * K; const bf16_t* Bg = Bt + (size_t)col0 * K;
#pragma unroll
  for (int mt = 0; mt < MT; ++mt)
#pragma unroll
    for (int nt = 0; nt < 4; ++nt) acc[mt][nt] = (f32x4){0.f, 0.f, 0.f, 0.f};
  const int srow = tid >> 3, sk = ((tid & 7) ^ (srow & 7)) * 8;
  const bf16_t* ga = Ag + (size_t)srow * K + sk; const bf16_t* gb = Bg + (size_t)srow * K + sk;
  const size_t pstep = (size_t)64 * K;
  const int nk = K / 64;
#define GT_DMA(st, k0) do { LAS unsigned char* lb_ = (LAS unsigned char*)smem + (st) * 65536 + w * 1024; \
    _Pragma("unroll") for (int i = 0; i < MT / 2; ++i) __builtin_amdgcn_global_load_lds((const unsigned*)(ga + i * pstep + (k0)), (LAS unsigned*)(lb_ + i * 8192), 16, 0, 0); \
    _Pragma("unroll") for (int i = 0; i < 4; ++i) __builtin_amdgcn_global_load_lds((const unsigned*)(gb + i * pstep + (k0)), (LAS unsigned*)(lb_ + 32768 + i * 8192), 16, 0, 0); } while (0)
  __syncthreads();
  GT_DMA(0, 0);
  asm volatile("s_waitcnt vmcnt(0)" ::: "memory");
  __syncthreads();
  const int sw = r & 7;
  for (int kt = 0; kt < nk; ++kt) {
    const int cur = kt & 1;
    if (kt + 1 < nk) GT_DMA(cur ^ 1, (kt + 1) * 64);
    const unsigned char* As = smem + cur * 65536; const unsigned char* Bs = As + 32768;
#pragma unroll
    for (int ks = 0; ks < 2; ++ks) {
      s16x8 af[MT], bfr[4];
      const int co = ((4 * ks + quad) ^ sw) * 16;
#pragma unroll
      for (int mt = 0; mt < MT; ++mt) af[mt] = *(const s16x8*)(As + (wm * 16 * MT + 16 * mt + r) * 128 + co);
#pragma unroll
      for (int nt = 0; nt < 4; ++nt) bfr[nt] = *(const s16x8*)(Bs + (wn * 64 + 16 * nt + r) * 128 + co);
#pragma unroll
      for (int mt = 0; mt < MT; ++mt)
#pragma unroll
        for (int nt = 0; nt < 4; ++nt) acc[mt][nt] = MFMA(bfr[nt], af[mt], acc[mt][nt]);
    }
    asm volatile("s_waitcnt vmcnt(0)" ::: "memory");
    __syncthreads();
  }
#undef GT_DMA
}

constexpr int LDT = 72;
DI void stage_row4(bf16_t* T, int mt, int nt, int lane, u32x2 v) { *(u32x2*)(T + (16 * (mt & 3) + (lane & 15)) * LDT + 16 * nt + 4 * (lane >> 4)) = v; }
DI void flush_rows(const bf16_t* T, bf16_t* __restrict__ g  , size_t stride, int lane) {
  asm volatile("s_waitcnt lgkmcnt(0)" ::: "memory");
#pragma unroll
  for (int u = 0; u < 8; ++u) { const int ch = u * 64 + lane, row = ch >> 3, k = ch & 7; *(u32x4*)(g + (size_t)row * stride + k * 8) = *(const u32x4*)(T + row * LDT + k * 8); }
  asm volatile("" ::: "memory");
}
#define FLUSH_IF(mt, gbase, stride) do { if (((mt) & 3) == 3) flush_rows(T, (gbase) + (size_t)(64 * ((mt) >> 2)) * (stride), (stride), lane); } while (0)

template <int MT>
DI void inproj_epi(const Params& P, int l, f32x4 (&acc)[MT][4], int rowb, int colb, int lane, unsigned char* smem_w) {
  bf16_t* T = (bf16_t*)smem_w;
  const int c = lane & 15, quad = lane >> 4;
  const bool lat = rowb >= 8192;
  bf16_t* mix = WSP(bf16_t, OFF_MIX);
  if (colb < 640) {
    const bool isq = colb < 512;
    const float* gain = (isq ? P.qn : P.kn) + l * 64;
    f32x4 gn[4];
#pragma unroll
    for (int nt = 0; nt < 4; ++nt) gn[nt] = *(const f32x4*)(gain + 16 * nt + 4 * quad);
#pragma unroll
    for (int mt = 0; mt < MT; ++mt) {
      const int token = rowb + 16 * mt + c;
      float ss = 0.f;
#pragma unroll
      for (int nt = 0; nt < 4; ++nt)
#pragma unroll
        for (int j = 0; j < 4; ++j) ss += acc[mt][nt][j] * acc[mt][nt][j];
      ss += __shfl_xor(ss, 16); ss += __shfl_xor(ss, 32);
      const float rinv = rsqrtf(ss * (1.f / 64.f) + 1e-6f);
      f32x4 v[4];
#pragma unroll
      for (int nt = 0; nt < 4; ++nt) v[nt] = acc[mt][nt] * rinv * gn[nt];
      const int n = (token - 8192) & 4095, bb = (token - 8192) >> 12;
      if (lat) {
        const int prow = n >> 6, pcol = n & 63;
        const f32x4 cr = *(const f32x4*)(WSP(float, OFF_T64C) + prow * 16 + 4 * quad), sr = *(const f32x4*)(WSP(float, OFF_T64S) + prow * 16 + 4 * quad);
        const f32x4 cc = *(const f32x4*)(WSP(float, OFF_T64C) + pcol * 16 + 4 * quad), sc = *(const f32x4*)(WSP(float, OFF_T64S) + pcol * 16 + 4 * quad);
        const f32x4 a0 = v[0] * cr - v[1] * sr, a1 = v[1] * cr + v[0] * sr, a2 = v[2] * cc - v[3] * sc, a3 = v[3] * cc + v[2] * sc;
        v[0] = a0; v[1] = a1; v[2] = a2; v[3] = a3;
      }
#pragma unroll
      for (int nt = 0; nt < 4; ++nt) stage_row4(T, mt, nt, lane, pk4(v[nt]));
      if (isq) FLUSH_IF(mt, WSP(bf16_t, OFF_QA) + (size_t)rowb * 512 + colb, 512);
      else {
        const int kc = colb - 512;
        if (!lat) {
          const int b = token >> 8, s = token & 255;
          float* o = P.out + OUT_GK + ((size_t)(b * 2 + l) * 256 + s) * 128 + kc + 4 * quad;
#pragma unroll
          for (int nt = 0; nt < 4; ++nt) *(f32x4*)(o + 16 * nt) = v[nt];
          FLUSH_IF(mt, WSP(bf16_t, OFF_KA_CTX) + (size_t)rowb * 128 + kc, 128);
        } else FLUSH_IF(mt, WSP(bf16_t, OFF_KA_LAT) + ((size_t)(l * 2 + ((rowb - 8192) >> 12)) * 4352 + 256 + ((rowb - 8192) & 4095)) * 128 + kc, 128);
      }
    }
  } else if (colb < 768) {
    const int vc = colb - 640, kvh = vc >> 6;
#pragma unroll
    for (int mt = 0; mt < MT; ++mt) {
      const int token = rowb + 16 * mt + c;
      bf16_t* dst; size_t dstr;
      if (!lat) {
        const int b = token >> 8, s = token & 255;
        float* o = P.out + OUT_GV + ((size_t)(b * 2 + l) * 256 + s) * 128 + vc + 4 * quad;
#pragma unroll
        for (int nt = 0; nt < 4; ++nt) *(f32x4*)(o + 16 * nt) = acc[mt][nt];
        dst = WSP(bf16_t, OFF_VTA_CTX) + ((size_t)(b * 2 + kvh) * 64) * 256 + s; dstr = 256;
      } else {
        const int n = (token - 8192) & 4095, bb = (token - 8192) >> 12;
        dst = WSP(bf16_t, OFF_VTA_LAT) + (((size_t)(l * 2 + bb) * 2 + kvh) * 64) * 4352 + 256 + n; dstr = 4352;
      }
#pragma unroll
      for (int nt = 0; nt < 4; ++nt)
#pragma unroll
        for (int j = 0; j < 4; ++j) dst[(size_t)(16 * nt + 4 * quad + j) * dstr] = f2bf(acc[mt][nt][j]);
    }
  } else if (colb < 1280 || (colb >= 2048 && colb < 2304) || colb >= 3328) {
    const int mc = colb < 1280 ? colb - 768 : (colb < 2304 ? 512 + colb - 2048 : 768 + colb - 3328);
#pragma unroll
    for (int mt = 0; mt < MT; ++mt) {
#pragma unroll
      for (int nt = 0; nt < 4; ++nt) stage_row4(T, mt, nt, lane, pk4(silu4(acc[mt][nt])));
      FLUSH_IF(mt, mix + (size_t)rowb * 1024 + mc, 1024);
    }
  } else if (colb < 1792) {
    const bool isq = colb < 1536;
#pragma unroll
    for (int mt = 0; mt < MT; ++mt) {
      const int token = rowb + 16 * mt + c;
      const int n = (token - 8192) & 4095, bb = (token - 8192) >> 12;
      f32x4 v[4];
#pragma unroll
      for (int nt = 0; nt < 4; ++nt) v[nt] = acc[mt][nt];
      if (lat) {
        const int prow = n >> 6, pcol = n & 63;
#pragma unroll
        for (int nt = 0; nt < 4; ++nt) {
          const int pos = (nt & 1) ? pcol : prow;
          const f32x4 cs = *(const f32x4*)(WSP(float, OFF_T32C) + pos * 8 + (quad & 1) * 4), sn = *(const f32x4*)(WSP(float, OFF_T32S) + pos * 8 + (quad & 1) * 4);
          f32x4 pr;
#pragma unroll
          for (int j = 0; j < 4; ++j) pr[j] = __shfl_xor(v[nt][j], 32);
          v[nt] = quad < 2 ? v[nt] * cs - pr * sn : v[nt] * cs + pr * sn;
        }
      }
#pragma unroll
      for (int nt = 0; nt < 4; ++nt) stage_row4(T, mt, nt, lane, pk4(v[nt]));
      if (isq) FLUSH_IF(mt, WSP(bf16_t, OFF_QD) + (size_t)rowb * 256 + (colb - 1280), 256);
      else {
        const int kc = colb - 1536;
        if (!lat) {
          const int b = token >> 8, s = token & 255;
          float* o = P.out + OUT_DK + ((size_t)(b * 2 + l) * 256 + s) * 256 + kc + 4 * quad;
#pragma unroll
          for (int nt = 0; nt < 4; ++nt) *(f32x4*)(o + 16 * nt) = v[nt];
          FLUSH_IF(mt, WSP(bf16_t, OFF_KD_CTX) + (size_t)rowb * 256 + kc, 256);
        } else FLUSH_IF(mt, WSP(bf16_t, OFF_KD_LAT) + ((size_t)(l * 2 + ((rowb - 8192) >> 12)) * 4352 + 256 + ((rowb - 8192) & 4095)) * 256 + kc, 256);
      }
    }
  } else if (colb < 2048) {
    const int vc = colb - 1792, h = vc >> 6;
#pragma unroll
    for (int mt = 0; mt < MT; ++mt) {
      const int token = rowb + 16 * mt + c;
      bf16_t* dst; size_t dstr;
      if (!lat) {
        const int b = token >> 8, s = token & 255;
        float* o = P.out + OUT_DV + ((size_t)(b * 2 + l) * 256 + s) * 256 + vc + 4 * quad;
#pragma unroll
        for (int nt = 0; nt < 4; ++nt) *(f32x4*)(o + 16 * nt) = acc[mt][nt];
        dst = WSP(bf16_t, OFF_VTD_CTX) + ((size_t)(b * 4 + h) * 64) * 256 + s; dstr = 256;
      } else {
        const int n = (token - 8192) & 4095, bb = (token - 8192) >> 12;
        dst = WSP(bf16_t, OFF_VTD_LAT) + (((size_t)(l * 2 + bb) * 4 + h) * 64) * 4352 + 256 + n; dstr = 4352;
      }
#pragma unroll
      for (int nt = 0; nt < 4; ++nt)
#pragma unroll
        for (int j = 0; j < 4; ++j) dst[(size_t)(16 * nt + 4 * quad + j) * dstr] = f2bf(acc[mt][nt][j]);
    }
  } else if (colb < 2560) {
#pragma unroll
    for (int mt = 0; mt < MT; ++mt) {
#pragma unroll
      for (int nt = 0; nt < 4; ++nt) stage_row4(T, mt, nt, lane, pk4(silu4(acc[mt][nt])));
      FLUSH_IF(mt, WSP(bf16_t, OFF_HQ) + (size_t)rowb * 256 + (colb - 2304), 256);
    }
  } else if (colb < 3072) {
    const int dir = colb < 2816 ? 0 : 1, cc0 = colb - (dir ? 2816 : 2560);
    float* G = WSP(float, dir ? OFF_GB : OFF_GF);
    f32x4 lb[4];
#pragma unroll
    for (int nt = 0; nt < 4; ++nt) lb[nt] = *(const f32x4*)(WSP(float, OFF_LBS) + (l * 2 + dir) * 256 + cc0 + 16 * nt + 4 * quad);
#pragma unroll
    for (int mt = 0; mt < MT; ++mt) {
      const int token = rowb + 16 * mt + c;
      float* dst = G + (size_t)token * 256 + cc0 + 4 * quad;
#pragma unroll
      for (int nt = 0; nt < 4; ++nt) {
        f32x4 g;
#pragma unroll
        for (int j = 0; j < 4; ++j) { const float f = lb[nt][j] + (1.f - lb[nt][j]) * sigmf(acc[mt][nt][j]); g[j] = logf(fmaxf(f, 1e-6f)); }
        *(f32x4*)(dst + 16 * nt) = g;
      }
    }
  } else {
#pragma unroll
    for (int mt = 0; mt < MT; ++mt) {
#pragma unroll
      for (int nt = 0; nt < 4; ++nt) stage_row4(T, mt, nt, lane, pk4(acc[mt][nt]));
      FLUSH_IF(mt, WSP(bf16_t, OFF_HV) + (size_t)rowb * 256 + (colb - 3072), 256);
    }
  }
}

DI void phase_inproj(const Params& P, int l, unsigned char* smem) {
  const bf16_t* A = WSP(bf16_t, OFF_H); const bf16_t* Bt = WSP(bf16_t, OFF_WINT) + (size_t)l * 3584 * 1024;
  const int xcd = blockIdx.x & 7, nbx = gridDim.x >> 3;
  for (int j = blockIdx.x >> 3; j < 96; j += nbx) {
    const int tid = otid(), lane = tid & 63, w = tid >> 6, wm = w >> 2, wn = w & 3;
    const int q = j & 31, pm = 8 * xcd + (q >> 2), pn = 4 * (j >> 5) + (q & 3);
    f32x4 acc[8][4];
    gemm_tile<8>(A, Bt, 1024, pm * 256, pn * 256, smem, acc);
    inproj_epi<8>(P, l, acc, pm * 256 + wm * 128, pn * 256 + wn * 64, lane, smem + w * 9216);
  }
  for (int j = blockIdx.x >> 3; j < 32; j += nbx) {
    const int tid = otid(), lane = tid & 63, w = tid >> 6, wm = w >> 2, wn = w & 3;
    const int pm = 8 * xcd + (j >> 2), pn = 12 + ((j >> 1) & 1), hm = j & 1;
    f32x4 acc[4][4];
    gemm_tile<4>(A, Bt, 1024, pm * 256 + hm * 128, pn * 256, smem, acc);
    inproj_epi<4>(P, l, acc, pm * 256 + hm * 128 + wm * 64, pn * 256 + wn * 64, lane, smem + w * 9216);
  }
}

DI void phase_outproj(const Params& P, int l, unsigned char* smem) {
  const bf16_t* A = WSP(bf16_t, OFF_MIX); const bf16_t* Bt = WSP(bf16_t, OFF_WOUTT) + (size_t)l * 1024 * 1024;
  const float* mod = WSP(float, OFF_MOD) + (size_t)l * 9216;
  const float alpha = 1.41421356237f;
  const int xcd = blockIdx.x & 7, nbx = gridDim.x >> 3;
  for (int j = blockIdx.x >> 3; j < 32; j += nbx) {
    const int tid = otid(), lane = tid & 63, w = tid >> 6, wm = w >> 2, wn = w & 3, c = lane & 15, quad = lane >> 4;
    const int pm = 8 * xcd + (j >> 2), pn = j & 3;
    f32x4 acc[8][4];
    gemm_tile<8>(A, Bt, 1024, pm * 256, pn * 256, smem, acc);
    const int rowb = pm * 256 + wm * 128, colb = pn * 256 + wn * 64;
#pragma unroll
    for (int mt = 0; mt < 8; ++mt) {
      const int token = rowb + 16 * mt + c;
      const int cond = token < 8192 ? 0 : 1 + ((token - 8192) >> 12);
      const float* xo = l == 0 ? (token < 8192 ? P.xp + (size_t)token * 1024 : P.xs + (size_t)(token - 8192) * 1024) : P.out + (size_t)token * 1024;
      bf16_t* T = (bf16_t*)(smem + w * 9216);
#pragma unroll
      for (int nt = 0; nt < 4; ++nt) {
        const int col = colb + 16 * nt + 4 * quad;
        const f32x4 g = *(const f32x4*)(mod + cond * 3072 + 2048 + col), xv = *(const f32x4*)(xo + col);
        stage_row4(T, mt, nt, lane, pk4(xv * alpha + g * acc[mt][nt]));
      }
      FLUSH_IF(mt, WSP(bf16_t, OFF_GF) + (size_t)rowb * 1024 + colb, 1024);
    }
  }
}

DI void phase_ln(const Params& P, int l, int dry = 0) {
  const int lane = threadIdx.x & 63, gw = blockIdx.x * (NT / 64) + (threadIdx.x >> 6), nw = gridDim.x * (NT / 64);
  const float* g = P.lng + l * 1024; const float* b = P.lnb + l * 1024;
  const float* mod1 = WSP(float, OFF_MOD) + 9216;
  constexpr int R = 4;
  for (int row0 = gw; row0 < 16384; row0 += nw * R) {
    f32x4 v[R][4]; float s[R], q[R];
#pragma unroll
    for (int rr = 0; rr < R; ++rr) {
      const int row = row0 + rr * nw;
      if (row < 16384) {
        const bf16_t* vp = WSP(bf16_t, OFF_GF) + (size_t)row * 1024;
#pragma unroll
        for (int i = 0; i < 4; ++i) v[rr][i] = unpk4(*(const u32x2*)(vp + i * 256 + lane * 4));
      }
    }
#pragma unroll
    for (int rr = 0; rr < R; ++rr) {
      const int row = row0 + rr * nw;
      if (row >= 16384) continue;
      float* y = P.out + (size_t)row * 1024;
      s[rr] = 0.f;
#pragma unroll
      for (int i = 0; i < 4; ++i) s[rr] += (v[rr][i][0] + v[rr][i][1]) + (v[rr][i][2] + v[rr][i][3]);
#pragma unroll
      for (int o = 1; o < 64; o <<= 1) s[rr] += __shfl_xor(s[rr], o);
      const float mu = s[rr] * (1.f / 1024.f); q[rr] = 0.f;
#pragma unroll
      for (int i = 0; i < 4; ++i) { v[rr][i] = v[rr][i] - mu; q[rr] += (v[rr][i][0] * v[rr][i][0] + v[rr][i][1] * v[rr][i][1]) + (v[rr][i][2] * v[rr][i][2] + v[rr][i][3] * v[rr][i][3]); }
#pragma unroll
      for (int o = 1; o < 64; o <<= 1) q[rr] += __shfl_xor(q[rr], o);
      const float rstd = rsqrtf(q[rr] * (1.f / 1024.f) + 1e-5f);
      const int cond = row < 8192 ? 0 : 1 + ((row - 8192) >> 12);
#pragma unroll
      for (int i = 0; i < 4; ++i) {
        const int col = i * 256 + lane * 4;
        const f32x4 o = v[rr][i] * rstd * *(const f32x4*)(g + col) + *(const f32x4*)(b + col);
        if (!dry) *(f32x4*)(y + col) = o;
        if (l == 0 && !dry) {
          const f32x4 h = o * (*(const f32x4*)(mod1 + cond * 3072 + 1024 + col) + 1.f) + *(const f32x4*)(mod1 + cond * 3072 + col);
          *(u32x2*)(WSP(bf16_t, OFF_H) + (size_t)row * 1024 + col) = pk4(h);
        }
      }
    }
  }
}

DI s16x8 scale8(s16x8 x, float sc) {
  const u32x4 u = __builtin_bit_cast(u32x4, x); u32x4 o;
  o.x = pk(bflo(u.x) * sc, bfhi(u.x) * sc); o.y = pk(bflo(u.y) * sc, bfhi(u.y) * sc); o.z = pk(bflo(u.z) * sc, bfhi(u.z) * sc); o.w = pk(bflo(u.w) * sc, bfhi(u.w) * sc);
  return __builtin_bit_cast(s16x8, o);
}
constexpr int LDV = 144;
constexpr int LDK = 80;
template <int MODE>
DI void attn_item(const Params& P, int l, const bf16_t* __restrict__ Qp  , int qstride,
                  const bf16_t* __restrict__ Kp  , int kstride, const bf16_t* __restrict__ VTp  , int T,
                  bf16_t* __restrict__ mixp  , unsigned char* smem, int dry = 0) {
  const int tid = otid(), lane = tid & 63, w = tid >> 6, r = lane & 15, quad = lane >> 4;
  constexpr int QW = MODE == 0 ? 32 : 16;
  const float sl2 = (MODE == 0 ? 0.125f : 0.17677669529663687f) * 1.4426950408889634f;
  s16x8 qf[2][2];
  if (MODE == 0) {
#pragma unroll
    for (int qt = 0; qt < 2; ++qt)
#pragma unroll
      for (int ks = 0; ks < 2; ++ks) qf[qt][ks] = scale8(*(const s16x8*)(Qp + (size_t)(w * QW + qt * 16 + r) * qstride + 32 * ks + 8 * quad), sl2);
  } else {
#pragma unroll
    for (int ks = 0; ks < 2; ++ks) { qf[0][ks] = scale8(*(const s16x8*)(Qp + (size_t)(w * QW + r) * qstride + 32 * ks + 8 * quad), sl2); qf[1][ks] = qf[0][ks]; }
  }
  float mref[2] = {0.f, 0.f};
  f32x4 lsT[2] = {{0.f, 0.f, 0.f, 0.f}, {0.f, 0.f, 0.f, 0.f}};
  const s16x8 ones = {0x3F80, 0x3F80, 0x3F80, 0x3F80, 0x3F80, 0x3F80, 0x3F80, 0x3F80};
  f32x4 oT[2][4];
#pragma unroll
  for (int p = 0; p < 2; ++p)
#pragma unroll
    for (int mt = 0; mt < 4; ++mt) oT[p][mt] = (f32x4){0.f, 0.f, 0.f, 0.f};
  unsigned char* Kb0 = smem;
  bf16_t* Vs0 = (bf16_t*)(smem + 32768);
  const int srow = tid >> 3, skc = ((tid & 7) ^ (srow & 7)) * 8;
  const int vrow = tid >> 4, vc8 = (tid & 15) * 8;
  const int vm = (tid & 3), vg = (vc8 & ~31);
  const int vp0 = vg + 8 * ((2 * vm) & 3) + 4 * (vm >> 1), vp1 = vg + 8 * ((2 * vm + 1) & 3) + 4 * (vm >> 1);
  u32x4 rv[2];
  const int nstage = T / 128;
#define AK_DMA(st_, buf_) do { LAS unsigned char* lb_ = (LAS unsigned char*)smem + (buf_) * 16384 + w * 1024; _Pragma("unroll") for (int i = 0; i < 2; ++i) \
    __builtin_amdgcn_global_load_lds((const unsigned*)(Kp + (size_t)((st_) * 128 + 64 * i + srow) * kstride + skc), (LAS unsigned*)(lb_ + i * 8192), 16, 0, 0); } while (0)
  __syncthreads();
  AK_DMA(0, 0);
#pragma unroll
  for (int i = 0; i < 2; ++i) rv[i] = *(const u32x4*)(VTp + (size_t)(32 * i + vrow) * T + vc8);
#pragma unroll
  for (int i = 0; i < 2; ++i) { *(u32x2*)(Vs0 + (32 * i + vrow) * LDV + vp0) = (u32x2){rv[i].x, rv[i].y}; *(u32x2*)(Vs0 + (32 * i + vrow) * LDV + vp1) = (u32x2){rv[i].z, rv[i].w}; }
  asm volatile("s_waitcnt vmcnt(0)" ::: "memory");
  __syncthreads();
  for (int st = 0; st < nstage; ++st) {
    if (st + 1 < nstage) {
      AK_DMA(st + 1, (st + 1) & 1);
      const int key0 = (st + 1) * 128;
#pragma unroll
      for (int i = 0; i < 2; ++i) rv[i] = *(const u32x4*)(VTp + (size_t)(32 * i + vrow) * T + key0 + vc8);
    }
    f32x4 sT[2][2][4];
#pragma unroll
    for (int hk = 0; hk < 2; ++hk) {
      const unsigned char* Ks = Kb0 + (st & 1) * 16384 + hk * 8192;
      s16x8 kf[4][2];
#pragma unroll
      for (int mt = 0; mt < 4; ++mt)
#pragma unroll
        for (int ks = 0; ks < 2; ++ks) kf[mt][ks] = *(const s16x8*)(Ks + (16 * mt + r) * 128 + (((4 * ks + quad) ^ (r & 7)) * 16));
      const f32x4 z0 = {-mref[0], -mref[0], -mref[0], -mref[0]}, z1 = {-mref[1], -mref[1], -mref[1], -mref[1]};
      if (MODE == 0) {
#pragma unroll
        for (int mt = 0; mt < 4; ++mt) { sT[hk][0][mt] = MFMA(kf[mt][0], qf[0][0], z0); sT[hk][1][mt] = MFMA(kf[mt][0], qf[1][0], z1); }
#pragma unroll
        for (int mt = 0; mt < 4; ++mt) { sT[hk][0][mt] = MFMA(kf[mt][1], qf[0][1], sT[hk][0][mt]); sT[hk][1][mt] = MFMA(kf[mt][1], qf[1][1], sT[hk][1][mt]); }
      } else {
#pragma unroll
        for (int mt = 0; mt < 4; ++mt) { sT[hk][0][mt] = MFMA(kf[mt][0], qf[0][0], z0); sT[hk][1][mt] = MFMA(kf[mt][1], qf[0][1], z1); }
      }
    }
#pragma unroll
   for (int hk = 0; hk < 2; ++hk) {
    const int kt = 2 * st + hk;
    const bf16_t* Vs = Vs0 + (st & 1) * 64 * LDV + hk * 64;
    s16x8 vf[4][2];
#pragma unroll
    for (int mt = 0; mt < 4; ++mt)
#pragma unroll
      for (int k2 = 0; k2 < 2; ++k2) {
        vf[mt][k2] = *(const s16x8*)(Vs + (16 * mt + r) * LDV + 32 * k2 + 8 * quad);
      }
    __builtin_amdgcn_sched_barrier(0);
    s16x8 pb[2][2];
#pragma unroll
    for (int p = 0; p < 2; ++p) {
      f32x4 pv[4];
      bool redo = (kt == 0);
      for (;;) {
        if (redo) {
          float mx = -1e30f;
#pragma unroll
          for (int mt = 0; mt < 4; ++mt)
#pragma unroll
            for (int j = 0; j < 4; ++j) mx = fmaxf(mx, sT[hk][p][mt][j]);
          mx = fmaxf(mx, __shfl_xor(mx, 16)); mx = fmaxf(mx, __shfl_xor(mx, 32));
          const float alpha = kt == 0 ? 0.f : __builtin_amdgcn_exp2f(-mx);
          mref[p] += mx; lsT[p] = lsT[p] * alpha;
#pragma unroll
          for (int mt = 0; mt < 4; ++mt) { oT[p][mt] = oT[p][mt] * alpha; sT[hk][p][mt] = sT[hk][p][mt] - mx; }
          if (hk == 0) {
#pragma unroll
            for (int mt = 0; mt < 4; ++mt) sT[1][p][mt] = sT[1][p][mt] - mx;
          }
        }
        if (!redo) {
          float mg = -1e30f;
#pragma unroll
          for (int mt = 0; mt < 4; ++mt)
#pragma unroll
            for (int j = 0; j < 4; ++j) mg = fmaxf(mg, sT[hk][p][mt][j]);
          if (__builtin_amdgcn_ballot_w64(!(mg < 20.f)) != 0ull) { redo = true; continue; }
        }
#pragma unroll
        for (int mt = 0; mt < 4; ++mt)
#pragma unroll
          for (int j = 0; j < 4; ++j) pv[mt][j] = __builtin_amdgcn_exp2f(sT[hk][p][mt][j]);
        break;
      }
#pragma unroll
      for (int k2 = 0; k2 < 2; ++k2) {
        u32x4 u; u.x = pk(pv[2 * k2][0], pv[2 * k2][1]); u.y = pk(pv[2 * k2][2], pv[2 * k2][3]);
        u.z = pk(pv[2 * k2 + 1][0], pv[2 * k2 + 1][1]); u.w = pk(pv[2 * k2 + 1][2], pv[2 * k2 + 1][3]);
        pb[p][k2] = __builtin_bit_cast(s16x8, u);
      }
    }
#pragma unroll
    for (int mt = 0; mt < 4; ++mt)
#pragma unroll
      for (int k2 = 0; k2 < 2; ++k2) {
        oT[0][mt] = MFMA(vf[mt][k2], pb[0][k2], oT[0][mt]);
        oT[1][mt] = MFMA(vf[mt][k2], pb[1][k2], oT[1][mt]);
      }
#pragma unroll
    for (int k2 = 0; k2 < 2; ++k2) { lsT[0] = MFMA(ones, pb[0][k2], lsT[0]); lsT[1] = MFMA(ones, pb[1][k2], lsT[1]); }
   }
    if (st + 1 < nstage) {
      bf16_t* Vd = Vs0 + ((st + 1) & 1) * 64 * LDV;
#pragma unroll
      for (int i = 0; i < 2; ++i) { *(u32x2*)(Vd + (32 * i + vrow) * LDV + vp0) = (u32x2){rv[i].x, rv[i].y}; *(u32x2*)(Vd + (32 * i + vrow) * LDV + vp1) = (u32x2){rv[i].z, rv[i].w}; }
    }
    asm volatile("s_waitcnt vmcnt(0)" ::: "memory");
    __syncthreads();
  }
#undef AK_DMA
  float inv[2];
#pragma unroll
  for (int p = 0; p < 2; ++p) inv[p] = 1.f / lsT[p][0];
  if (dry) return;
  if (MODE == 0) {
#pragma unroll
    for (int qt = 0; qt < 2; ++qt) {
      bf16_t* dst = mixp + (size_t)(w * QW + qt * 16 + r) * 1024 + 4 * quad;
#pragma unroll
      for (int mt = 0; mt < 4; ++mt) {
        const f32x4 g = unpk4(*(const u32x2*)(dst + 16 * mt));
        *(u32x2*)(dst + 16 * mt) = pk4(oT[qt][mt] * inv[qt] * g);
      }
    }
  } else {
    const float lam = WSP(float, OFF_LAM)[l];
    const float li = 0.8f - 0.6f * expf(-0.3f * (float)l);
    f32x4 o[4]; float ss = 0.f;
#pragma unroll
    for (int mt = 0; mt < 4; ++mt) { o[mt] = oT[0][mt] * inv[0] - oT[1][mt] * (inv[1] * lam); ss += (o[mt][0] * o[mt][0] + o[mt][1] * o[mt][1]) + (o[mt][2] * o[mt][2] + o[mt][3] * o[mt][3]); }
    ss += __shfl_xor(ss, 16); ss += __shfl_xor(ss, 32);
    const float rinv = rsqrtf(ss * (1.f / 64.f) + 1e-6f) * (1.f - li);
    bf16_t* dst = mixp + (size_t)(w * QW + r) * 1024 + 4 * quad;
#pragma unroll
    for (int mt = 0; mt < 4; ++mt) {
      const f32x4 g = unpk4(*(const u32x2*)(dst + 16 * mt));
      const f32x4 sub = *(const f32x4*)(P.dsub + l * 64 + 16 * mt + 4 * quad);
      *(u32x2*)(dst + 16 * mt) = pk4(o[mt] * rinv * sub * g);
    }
  }
}

DI void mm64(const bf16_t* A, const bf16_t* Bt, int w, int lane, f32x4 (&acc)[4]) {
  const int r = lane & 15, quad = lane >> 4;
#pragma unroll
  for (int ks = 0; ks < 2; ++ks) {
    const s16x8 a = *(const s16x8*)(A + (16 * w + r) * LD + 32 * ks + 8 * quad);
#pragma unroll
    for (int nt = 0; nt < 4; ++nt) { const s16x8 b = *(const s16x8*)(Bt + (16 * nt + r) * LD + 32 * ks + 8 * quad); acc[nt] = MFMA(a, b, acc[nt]); }
  }
}

DI void hgrn_gates(const float* __restrict__ garr, int tok0, int h, int dir, float* bt  , float (&gv)[16], float (&dG)[16], float& glm, float& Mv) {
  const int tid = otid() & 255, kk = tid & 63, q4 = tid >> 6;
  float run = 0.f;
#pragma unroll
  for (int i = 0; i < 16; ++i) { const int t = 16 * q4 + i, token = dir ? tok0 + 63 - t : tok0 + t; gv[i] = garr[(size_t)token * 256 + h * 64 + kk]; }
#pragma unroll
  for (int i = 0; i < 16; ++i) { run += gv[i]; dG[i] = run; }
  bt[q4 * 64 + kk] = run;
  __syncthreads();
  const float b0 = bt[kk], b1 = bt[64 + kk], b2 = bt[128 + kk], b3 = bt[192 + kk];
  const float R = q4 == 0 ? 0.f : (q4 == 1 ? b0 : (q4 == 2 ? b0 + b1 : b0 + b1 + b2));
  Mv = b0 + b1; glm = b2 + b3;
#pragma unroll
  for (int i = 0; i < 16; ++i) dG[i] = R + dG[i] - Mv;
}

DI void hgrn_a_item(const Params& P, int pair, unsigned char* smem0) {
  const int tid0 = otid(), tid = tid0 & 255, lane = tid & 63, w = tid >> 6, kk = tid & 63, q4 = tid >> 6;
  const int it = 2 * pair + (tid0 >> 8); unsigned char* smem = smem0 + (tid0 >> 8) * HALF_LDS;
  const int dir = it & 1, h = (it >> 1) & 3, tc = it >> 3, tok0 = tc * 64;
  bf16_t* KT = (bf16_t*)smem; bf16_t* VT = KT + 64 * LD; float* bt = (float*)(smem + 40960); float* scl = bt + 256;
  __syncthreads();
  float gv[16], dG[16], glm, Mv;
  float vv[16];
  {
    const bf16_t* hv = WSP(bf16_t, OFF_HV);
#pragma unroll
    for (int i = 0; i < 16; ++i) { const int t = 16 * q4 + i, token = dir ? tok0 + 63 - t : tok0 + t; vv[i] = bf2f(hv[(size_t)token * 256 + h * 64 + kk]); }
  }
  hgrn_gates(WSP(float, dir ? OFF_GB : OFF_GF), tok0, h, dir, bt, gv, dG, glm, Mv);
  {
    u32x4 u0, u1; float kh[16];
#pragma unroll
    for (int i = 0; i < 16; ++i) kh[i] = (1.f - __expf(gv[i])) * __expf(fminf(-dG[i], 80.f));
    u0.x = pk(kh[0], kh[1]); u0.y = pk(kh[2], kh[3]); u0.z = pk(kh[4], kh[5]); u0.w = pk(kh[6], kh[7]);
    u1.x = pk(kh[8], kh[9]); u1.y = pk(kh[10], kh[11]); u1.z = pk(kh[12], kh[13]); u1.w = pk(kh[14], kh[15]);
    *(u32x4*)(KT + kk * LD + 16 * q4) = u0; *(u32x4*)(KT + kk * LD + 16 * q4 + 8) = u1;
    if (q4 == 0) { scl[kk] = __expf(glm); WSP(float, OFF_HP)[(size_t)it * 64 + kk] = __expf(glm + Mv); }
    u0.x = pk(vv[0], vv[1]); u0.y = pk(vv[2], vv[3]); u0.z = pk(vv[4], vv[5]); u0.w = pk(vv[6], vv[7]);
    u1.x = pk(vv[8], vv[9]); u1.y = pk(vv[10], vv[11]); u1.z = pk(vv[12], vv[13]); u1.w = pk(vv[14], vv[15]);
    *(u32x4*)(VT + kk * LD + 16 * q4) = u0; *(u32x4*)(VT + kk * LD + 16 * q4 + 8) = u1;
  }
  __syncthreads();
  f32x4 acc[4];
#pragma unroll
  for (int nt = 0; nt < 4; ++nt) acc[nt] = (f32x4){0.f, 0.f, 0.f, 0.f};
  mm64(KT, VT, w, lane, acc);
  float* U = WSP(float, OFF_HS) + (size_t)it * 4096;
  const int c = lane & 15, quad = lane >> 4;
#pragma unroll
  for (int j = 0; j < 4; ++j) {
    const int k = 16 * w + 4 * quad + j; const float s = scl[k];
#pragma unroll
    for (int nt = 0; nt < 4; ++nt) U[k * 64 + 16 * nt + c] = acc[nt][j] * s;
  }
}

DI void hgrn_b_item(const Params& P, int l, int it, unsigned char* smem) {
  const int tid = otid(), g = tid >> 6, e = tid & 63;
  const int sq = it >> 6, b = sq >> 3, h = (sq >> 1) & 3, dir = sq & 1, eg = it & 63, kv = eg * 64 + e, c0 = 128 + b * 64;
  float* HS = WSP(float, OFF_HS); const float* HP = WSP(float, OFF_HP);
  float* gp = (float*)smem; float* gu = gp + 512;
  float U[8], Pd[8];
#pragma unroll
  for (int u = 0; u < 8; ++u) { const int ci = 8 * g + u, tc = dir ? c0 + 63 - ci : c0 + ci; const size_t idx = (size_t)(tc * 4 + h) * 2 + dir; U[u] = HS[idx * 4096 + kv]; Pd[u] = HP[idx * 64 + eg]; }
  float S = P.st[((size_t)((b * 2 + l) * 2 + dir) * 4 + h) * 4096 + kv];
  float Pg = 1.f, Ug = 0.f;
#pragma unroll
  for (int u = 0; u < 8; ++u) { Ug = Pd[u] * Ug + U[u]; Pg *= Pd[u]; }
  __syncthreads();
  gp[g * 64 + e] = Pg; gu[g * 64 + e] = Ug;
  __syncthreads();
  for (int gg = 0; gg < g; ++gg) S = gp[gg * 64 + e] * S + gu[gg * 64 + e];
#pragma unroll
  for (int u = 0; u < 8; ++u) { const int ci = 8 * g + u, tc = dir ? c0 + 63 - ci : c0 + ci; const size_t idx = (size_t)(tc * 4 + h) * 2 + dir; HS[idx * 4096 + kv] = S; S = Pd[u] * S + U[u]; }
}

DI void hgrn_c_item(const Params& P, int l, int pair, unsigned char* smem0, int dry = 0) {
  const int tid0 = otid(), tid = tid0 & 255, lane = tid & 63, w = tid >> 6, kk = tid & 63, q4 = tid >> 6, c = lane & 15, quad = lane >> 4;
  const int it = 2 * pair + (tid0 >> 8); unsigned char* smem = smem0 + (tid0 >> 8) * HALF_LDS;
  const int h = it & 3, tc = it >> 2, tok0 = tc * 64;
  bf16_t* QH = (bf16_t*)smem; bf16_t* KH = QH + 64 * LD; bf16_t* VT = KH + 64 * LD; bf16_t* ST = VT + 64 * LD; bf16_t* AM = KH;
  float* bt = (float*)(smem + 40960); float* em = bt + 256;
  f32x4 ob[4], of[4];
#pragma unroll
  for (int dd = 0; dd < 2; ++dd) {
    const int dir = 1 - dd;
    const size_t idx = (size_t)(tc * 4 + h) * 2 + dir;
    __syncthreads();
    const float* HSb = WSP(float, OFF_HS); const float* HPb = WSP(float, OFF_HP);
    const float* Sp = HSb + idx * 4096;
    const int cq = tc & ~3, pos = dir ? cq + 3 - tc : tc - cq;
    const int kb = tid >> 6, vv0 = tid & 63;
    float sv[16], qv[16], vv[16];
    {
      const bf16_t* hq = WSP(bf16_t, OFF_HQ); const bf16_t* hv = WSP(bf16_t, OFF_HV);
#pragma unroll
      for (int i = 0; i < 16; ++i) {
        const int t = 16 * q4 + i, token = dir ? tok0 + 63 - t : tok0 + t;
        qv[i] = bf2f(hq[(size_t)token * 256 + h * 64 + kk]); vv[i] = bf2f(hv[(size_t)token * 256 + h * 64 + kk]);
      }
    }
    if (tc >= 128) {
#pragma unroll
      for (int e = 0; e < 16; ++e) sv[e] = Sp[tid + 256 * e];
    } else {
#pragma unroll
      for (int e = 0; e < 16; ++e) sv[e] = 0.f;
      for (int ci = 0; ci < pos; ++ci) {
        const int tcp = dir ? cq + 3 - ci : cq + ci; const size_t ip = (size_t)(tcp * 4 + h) * 2 + dir;
        float uu[16], pp[16];
#pragma unroll
        for (int e = 0; e < 16; ++e) { uu[e] = HSb[ip * 4096 + tid + 256 * e]; pp[e] = HPb[ip * 64 + kb + 4 * e]; }
#pragma unroll
        for (int e = 0; e < 16; ++e) sv[e] = pp[e] * sv[e] + uu[e];
      }
      if (pos == 3 && !dry) {
        float* op = P.out + OUT_ST + ((size_t)(((tc >> 2) * 2 + l) * 2 + dir) * 4 + h) * 4096;
#pragma unroll
        for (int e = 0; e < 16; ++e) op[tid + 256 * e] = HPb[idx * 64 + kb + 4 * e] * sv[e] + Sp[tid + 256 * e];
      }
    }
    float gv[16], dG[16], glm, Mv;
    hgrn_gates(WSP(float, dir ? OFF_GB : OFF_GF), tok0, h, dir, bt, gv, dG, glm, Mv);
    {
#pragma unroll
      for (int i = 0; i < 16; ++i) {
        const int t = 16 * q4 + i;
        QH[t * LD + kk] = f2bf(qv[i] * __expf(fminf(dG[i], 80.f)));
        KH[t * LD + kk] = f2bf((1.f - __expf(gv[i])) * __expf(fminf(-dG[i], 80.f)));
      }
      u32x4 u0, u1;
      u0.x = pk(vv[0], vv[1]); u0.y = pk(vv[2], vv[3]); u0.z = pk(vv[4], vv[5]); u0.w = pk(vv[6], vv[7]);
      u1.x = pk(vv[8], vv[9]); u1.y = pk(vv[10], vv[11]); u1.z = pk(vv[12], vv[13]); u1.w = pk(vv[14], vv[15]);
      *(u32x4*)(VT + kk * LD + 16 * q4) = u0; *(u32x4*)(VT + kk * LD + 16 * q4 + 8) = u1;
      const float emk = __expf(Mv);
      if (q4 == 0) em[kk] = emk;
    }
    __syncthreads();
#pragma unroll
    for (int e = 0; e < 16; ++e) ST[vv0 * LD + kb + 4 * e] = f2bf(sv[e] * em[kb + 4 * e]);
    __syncthreads();
    f32x4 aa[4];
#pragma unroll
    for (int nt = 0; nt < 4; ++nt) aa[nt] = (f32x4){0.f, 0.f, 0.f, 0.f};
    mm64(QH, KH, w, lane, aa);
    __syncthreads();
#pragma unroll
    for (int j = 0; j < 4; ++j) {
      const int t = 16 * w + 4 * quad + j;
#pragma unroll
      for (int nt = 0; nt < 4; ++nt) { const int s = 16 * nt + c; AM[t * LD + s] = f2bf(s <= t ? aa[nt][j] : 0.f); }
    }
    __syncthreads();
    f32x4 acc[4];
#pragma unroll
    for (int nt = 0; nt < 4; ++nt) acc[nt] = (f32x4){0.f, 0.f, 0.f, 0.f};
    mm64(AM, VT, w, lane, acc);
    mm64(QH, ST, w, lane, acc);
    if (dd == 0) {
#pragma unroll
      for (int nt = 0; nt < 4; ++nt) ob[nt] = acc[nt];
    } else {
#pragma unroll
      for (int nt = 0; nt < 4; ++nt) of[nt] = acc[nt];
    }
  }
  __syncthreads();
  float* OB = (float*)smem;
#pragma unroll
  for (int j = 0; j < 4; ++j)
#pragma unroll
    for (int nt = 0; nt < 4; ++nt) OB[(16 * w + 4 * quad + j) * 64 + 16 * nt + c] = ob[nt][j];
  __syncthreads();
  bf16_t* mix = WSP(bf16_t, OFF_MIX);
#pragma unroll
  for (int j = 0; j < 4; ++j) {
    const int t = 16 * w + 4 * quad + j;
    float o[4], ss = 0.f;
#pragma unroll
    for (int nt = 0; nt < 4; ++nt) { o[nt] = of[nt][j] + OB[(63 - t) * 64 + 16 * nt + c]; ss += o[nt] * o[nt]; }
    ss += __shfl_xor(ss, 1); ss += __shfl_xor(ss, 2); ss += __shfl_xor(ss, 4); ss += __shfl_xor(ss, 8);
    const float rinv = rsqrtf(ss * (1.f / 64.f) + 1e-6f);
    bf16_t* dst = mix + (size_t)(tok0 + t) * 1024 + 768 + h * 64 + c;
    if (!dry)
#pragma unroll
    for (int nt = 0; nt < 4; ++nt) dst[16 * nt] = f2bf(o[nt] * rinv * P.hnorm[l * 64 + 16 * nt + c] * bf2f(dst[16 * nt]));
  }
}

DI void phase_mixers(const Params& P, int l, unsigned char* smem, int dry = 0) {
  const int xcd = blockIdx.x & 7, nbx = gridDim.x >> 3;
  for (int j = blockIdx.x >> 3; j < 64; j += nbx) {
    const int b = xcd >> 2;
    if (j < 32) {
      const int hq = 2 * (xcd & 3) + (j >> 4), qb = j & 15, kvh = hq >> 2;
      const int tokq = 8192 + b * 4096 + qb * 256;
      attn_item<0>(P, l, WSP(bf16_t, OFF_QA) + (size_t)tokq * 512 + hq * 64, 512,
                   WSP(bf16_t, OFF_KA_LAT) + (size_t)(l * 2 + b) * 4352 * 128 + kvh * 64, 128,
                   WSP(bf16_t, OFF_VTA_LAT) + ((size_t)(l * 2 + b) * 2 + kvh) * 64 * 4352, 4352,
                   WSP(bf16_t, OFF_MIX) + (size_t)tokq * 1024 + hq * 64, smem, dry);
    } else {
      const int h = xcd & 3, qb = j - 32;
      const int tokq = 8192 + b * 4096 + qb * 128;
      attn_item<1>(P, l, WSP(bf16_t, OFF_QD) + (size_t)tokq * 256 + h * 64, 256,
                   WSP(bf16_t, OFF_KD_LAT) + (size_t)(l * 2 + b) * 4352 * 256 + h * 64, 256,
                   WSP(bf16_t, OFF_VTD_LAT) + ((size_t)(l * 2 + b) * 4 + h) * 64 * 4352, 4352,
                   WSP(bf16_t, OFF_MIX) + (size_t)tokq * 1024 + 512 + h * 64, smem, dry);
    }
  }
  for (int it = blockIdx.x; it < 1536; it += gridDim.x) {
    if (it < 256) {
      const int b = it >> 3, hq = it & 7, kvh = hq >> 2;
      const int tokq = b * 256;
      attn_item<0>(P, l, WSP(bf16_t, OFF_QA) + (size_t)tokq * 512 + hq * 64, 512,
                   WSP(bf16_t, OFF_KA_CTX) + (size_t)b * 256 * 128 + kvh * 64, 128,
                   WSP(bf16_t, OFF_VTA_CTX) + (size_t)(b * 2 + kvh) * 64 * 256, 256,
                   WSP(bf16_t, OFF_MIX) + (size_t)tokq * 1024 + hq * 64, smem, dry);
    } else if (it < 512) {
      const int i2 = it - 256, b = i2 >> 3, h = (i2 >> 1) & 3, qb = i2 & 1;
      const int tokq = b * 256 + qb * 128;
      attn_item<1>(P, l, WSP(bf16_t, OFF_QD) + (size_t)tokq * 256 + h * 64, 256,
                   WSP(bf16_t, OFF_KD_CTX) + (size_t)b * 256 * 256 + h * 64, 256,
                   WSP(bf16_t, OFF_VTD_CTX) + (size_t)(b * 4 + h) * 64 * 256, 256,
                   WSP(bf16_t, OFF_MIX) + (size_t)tokq * 1024 + 512 + h * 64, smem, dry);
    } else hgrn_a_item(P, it - 512, smem);
  }
}

__global__ void __launch_bounds__(NT, 2) fwd_megakernel(Params P) {
  cg::grid_group grid = cg::this_grid();
  extern __shared__ __attribute__((aligned(16))) unsigned char smem[];
  __shared__ uint4 xb_words;
  if (threadIdx.x == 0) xb_words = make_uint4(0u, 0u, 0u, 0u);
  __syncthreads();
  const XcdBarrier xb = xcd_barrier_post(WSP(unsigned, OFF_BAR), (volatile LAS unsigned*)&xb_words);
  if (P.out == nullptr) grid.sync();
#define GSYNC() xcd_barrier(xb)
  for (int it = blockIdx.x; it < P0_ITEMS; it += gridDim.x) p0_item(P, it, smem);
  GSYNC();
  p0b(P);
  GSYNC();
#pragma unroll 1
  for (int l = 0; l < 2; ++l) {
    phase_inproj(P, l, smem);
    GSYNC();
    phase_mixers(P, l, smem);
    GSYNC();
    for (int it = blockIdx.x; it < 1024; it += gridDim.x) hgrn_b_item(P, l, it, smem);
    GSYNC();
    for (int it = blockIdx.x; it < 512; it += gridDim.x) hgrn_c_item(P, l, it, smem);
    GSYNC();
    phase_outproj(P, l, smem);
    GSYNC();
    phase_ln(P, l);
    if (l == 0) GSYNC();
  }
}

extern "C" void kernel_launch(void* const* d_in, const int* in_sizes, int n_in, void* d_out, int out_size,
                              void* d_ws, size_t ws_size, hipStream_t stream) {
  static int grid_blocks = 0;
  if (!grid_blocks) {
    int dev = 0, cus = 0, per_cu = 0;
    (void)hipGetDevice(&dev);
    (void)hipDeviceGetAttribute(&cus, hipDeviceAttributeMultiprocessorCount, dev);
    if (hipFuncSetAttribute((const void*)fwd_megakernel, hipFuncAttributeMaxDynamicSharedMemorySize, SMEM_BYTES) != hipSuccess) fprintf(stderr, "hipFuncSetAttribute failed\n");
    (void)hipOccupancyMaxActiveBlocksPerMultiprocessor(&per_cu, (const void*)fwd_megakernel, NT, SMEM_BYTES);
    if (per_cu < 1) per_cu = 1;
    if (per_cu > 1) per_cu = 1;
    grid_blocks = cus * per_cu;
  }
  if (ws_size < WS_END) { fprintf(stderr, "workspace too small: %zu < %zu\n", ws_size, (size_t)WS_END); return; }
  Params p{};
  const float* const* in = (const float* const*)d_in;
  p.xp = in[0]; p.xs = in[1]; p.cgk = in[2]; p.cgv = in[3]; p.cdk = in[4]; p.cdv = in[5]; p.st = in[6]; p.c = in[7]; p.cctx = in[8];
  p.wada = in[9]; p.bada = in[10]; p.win = in[11]; p.qn = in[12]; p.kn = in[13]; p.dlam = in[14]; p.dsub = in[15]; p.hlb = in[16]; p.hnorm = in[17];
  p.wout = in[18]; p.lng = in[19]; p.lnb = in[20];
  p.out = (float*)d_out; p.ws = (unsigned char*)d_ws;
  (void)hipMemsetAsync((unsigned char*)d_ws + OFF_MOD, 0, 73728, stream);
  (void)hipMemsetAsync((unsigned char*)d_ws + OFF_BAR, 0, XCD_BAR_WORDS * 4, stream);
  void* args[] = {&p};
  hipError_t e = hipLaunchCooperativeKernel((void*)fwd_megakernel, dim3(grid_blocks), dim3(NT), args, SMEM_BYTES, stream);
  if (e != hipSuccess) fprintf(stderr, "cooperative launch failed: %s (grid %d)\n", hipGetErrorString(e), grid_blocks);
}
```

```cpp
#include <hip/hip_runtime.h>
#include <hip/hip_cooperative_groups.h>
#include <cstdio>
#include <cstdint>
namespace cg = cooperative_groups;
#define DI __device__ __forceinline__
typedef unsigned short bf16_t;
typedef short s16x8 __attribute__((ext_vector_type(8)));
typedef short s16x4 __attribute__((ext_vector_type(4)));
typedef float f32x4 __attribute__((ext_vector_type(4)));
typedef float f32x2 __attribute__((ext_vector_type(2)));
typedef unsigned u32x4 __attribute__((ext_vector_type(4)));
typedef unsigned u32x2 __attribute__((ext_vector_type(2)));
typedef __bf16 bf2_t __attribute__((ext_vector_type(2)));
#define LAS __attribute__((address_space(3)))

struct Params {
  const float *xp, *xs, *cgk, *cgv, *cdk, *cdv, *st, *c, *cctx, *wada, *bada, *win, *qn, *kn, *dlam, *dsub, *hlb, *hnorm, *wout, *lng, *lnb;
  float* out; unsigned char* ws;
};

constexpr size_t OFF_MOD = 0;
constexpr size_t OFF_LBS = 73728;
constexpr size_t OFF_LAM = OFF_LBS + 4096;
constexpr size_t OFF_T64C = OFF_LAM + 256;
constexpr size_t OFF_T64S = OFF_T64C + 4096;
constexpr size_t OFF_T32C = OFF_T64S + 4096;
constexpr size_t OFF_T32S = OFF_T32C + 2048;
constexpr size_t OFF_BAR = 131072;
constexpr size_t OFF_WINT = 1u << 20;
constexpr size_t OFF_WOUTT = OFF_WINT + 14680064;
constexpr size_t OFF_H = OFF_WOUTT + 4194304;
constexpr size_t OFF_QA = OFF_H + 33554432;
constexpr size_t OFF_MIX = OFF_QA + 16777216;
constexpr size_t OFF_QD = OFF_MIX + 33554432;
constexpr size_t OFF_KA_CTX = OFF_QD + 8388608;
constexpr size_t OFF_VTA_CTX = OFF_KA_CTX + 2097152;
constexpr size_t OFF_KD_CTX = OFF_VTA_CTX + 2097152;
constexpr size_t OFF_VTD_CTX = OFF_KD_CTX + 4194304;
constexpr size_t OFF_KA_LAT = OFF_VTD_CTX + 4194304;
constexpr size_t OFF_VTA_LAT = OFF_KA_LAT + 4456448;
constexpr size_t OFF_KD_LAT = OFF_VTA_LAT + 4456448;
constexpr size_t OFF_VTD_LAT = OFF_KD_LAT + 8912896;
constexpr size_t OFF_HQ = OFF_VTD_LAT + 8912896;
constexpr size_t OFF_HV = OFF_HQ + 8388608;
constexpr size_t OFF_GF = OFF_HV + 8388608;
constexpr size_t OFF_GB = OFF_GF + 16777216;
constexpr size_t OFF_HS = OFF_GB + 16777216;
constexpr size_t OFF_HP = OFF_HS + 33554432;
constexpr size_t WS_END = OFF_HP + 524288;

constexpr size_t OUT_GK = 16777216, OUT_GV = 18874368, OUT_DK = 20971520, OUT_DV = 25165824, OUT_ST = 29360128;

constexpr int LD = 80;
constexpr int NT = 512;
constexpr int SMEM_BYTES = 131072;
constexpr int HALF_LDS = 43008;

DI unsigned pk(float a, float b) { f32x2 v = {a, b}; bf2_t r = __builtin_convertvector(v, bf2_t); return __builtin_bit_cast(unsigned, r); }
DI bf16_t f2bf(float a) { return (bf16_t)(pk(a, 0.f) & 0xffffu); }
DI float bf2f(bf16_t u) { return __uint_as_float((unsigned)u << 16); }
DI float bflo(unsigned u) { return __uint_as_float(u << 16); }
DI float bfhi(unsigned u) { return __uint_as_float(u & 0xffff0000u); }
DI u32x2 pk4(f32x4 v) { u32x2 r; r.x = pk(v[0], v[1]); r.y = pk(v[2], v[3]); return r; }
DI f32x4 unpk4(u32x2 u) { f32x4 r; r[0] = bflo(u.x); r[1] = bfhi(u.x); r[2] = bflo(u.y); r[3] = bfhi(u.y); return r; }
DI float siluf(float x) { return x * __builtin_amdgcn_rcpf(1.f + __expf(-x)); }
DI float sigmf(float x) { return __builtin_amdgcn_rcpf(1.f + __expf(-x)); }
DI f32x4 silu4(f32x4 v) { f32x4 r; for (int j = 0; j < 4; ++j) r[j] = siluf(v[j]); return r; }
#define MFMA(a, b, c) __builtin_amdgcn_mfma_f32_16x16x32_bf16((a), (b), (c), 0, 0, 0)
#define WSP(T, off) ((T*)(P.ws + (off)))
DI int otid() { int t = threadIdx.x; asm volatile("" : "+v"(t)); return t; }


#define XB_TMO      128
#define XB_XCNT(j)  (256  + 64 * (j))
#define XB_XSUB(j)  (1280 + 64 * (j))
#define XB_XGEN(j)  (2304 + 64 * (j))
#define XB_TOP      3328
#define XB_TOPGEN   3392
#define XCD_BAR_WORDS 3456
#define XB_SPIN_CAP (1u << 22)
DI unsigned xb_ld(unsigned* p)              { return __hip_atomic_load(p, __ATOMIC_RELAXED, __HIP_MEMORY_SCOPE_AGENT); }
DI unsigned xb_add(unsigned* p, unsigned v) { return __hip_atomic_fetch_add(p, v, __ATOMIC_RELAXED, __HIP_MEMORY_SCOPE_AGENT); }
DI unsigned xb_xcc_id() { return (unsigned)__builtin_amdgcn_s_getreg((3 << 11) | 20) & 0xFu; }
#define XB_SPIN(cond, bar) do { unsigned _sp = 0; while (cond) { __builtin_amdgcn_s_sleep(1); \
    if ((++_sp & 255u) == 0u) { if (xb_ld(&(bar)[XB_TMO])) break; if (_sp > XB_SPIN_CAP) { atomicAdd(&(bar)[XB_TMO], 1u); break; } } } } while (0)
struct XcdBarrier { unsigned* bar; unsigned x; volatile LAS unsigned* st; };
DI XcdBarrier xcd_barrier_post(unsigned* bar, volatile LAS unsigned* st) {
  XcdBarrier b; b.bar = bar; b.x = xb_xcc_id(); b.st = st;
  if (threadIdx.x == 0) (void)xb_add(&bar[XB_XCNT(b.x)], 1u);
  return b;
}
DI void xcd_barrier_complete(unsigned* bar, unsigned x, unsigned& nloc, unsigned& nx) {
  const unsigned G = gridDim.x * gridDim.y * gridDim.z;
  unsigned sum, cnt, mine, sp = 0u;
  for (;;) {
    sum = 0u; cnt = 0u; mine = 0u;
#pragma unroll
    for (unsigned j = 0; j < 16; ++j) { const unsigned c = xb_ld(&bar[XB_XCNT(j)]); sum += c; cnt += (c > 0u) ? 1u : 0u; mine = (j == x) ? c : mine; }
    if (sum == G) break;
    __builtin_amdgcn_s_sleep(1);
    if ((++sp & 255u) == 0u) { if (xb_ld(&bar[XB_TMO])) break; if (sp > XB_SPIN_CAP) { atomicAdd(&bar[XB_TMO], 1u); break; } }
  }
  nloc = mine > 0u ? mine : 1u; nx = cnt > 0u ? cnt : 1u;
}
DI void xcd_barrier(const XcdBarrier& b) {
  asm volatile("s_waitcnt vmcnt(0)" ::: "memory");
  __syncthreads();
  if (threadIdx.x == 0) {
    unsigned* bar = b.bar;
    __builtin_amdgcn_s_waitcnt(0);
    unsigned nloc = b.st[0], nx = b.st[1];
    if (nloc == 0u) { xcd_barrier_complete(bar, b.x, nloc, nx); b.st[0] = nloc; b.st[1] = nx; }
    const unsigned old = xb_add(&bar[XB_XSUB(b.x)], 1u);
    const unsigned gen = old / nloc;
    if (old + 1u == (gen + 1u) * nloc) {
      __builtin_amdgcn_fence(__ATOMIC_RELEASE, "agent");
      asm volatile("s_waitcnt vmcnt(0)" ::: "memory");
      const unsigned og = xb_add(&bar[XB_TOP], 1u);
      const unsigned tg = og / nx;
      if (og + 1u == (tg + 1u) * nx) xb_add(&bar[XB_TOPGEN], 1u);
      else XB_SPIN(xb_ld(&bar[XB_TOPGEN]) == tg, bar);
      __builtin_amdgcn_fence(__ATOMIC_ACQUIRE, "agent");
      xb_add(&bar[XB_XGEN(b.x)], 1u);
      asm volatile("s_waitcnt vmcnt(0)" ::: "memory");
    } else {
      XB_SPIN(xb_ld(&bar[XB_XGEN(b.x)]) == gen, bar);
      __builtin_amdgcn_fence(__ATOMIC_ACQUIRE, "agent");
      asm volatile("s_waitcnt vmcnt(0)" ::: "memory");
    }
  }
  __syncthreads();
}

constexpr int P0_ITEMS = 192 + 1152 + 192 + 1;
DI void p0_item(const Params& P, int it, unsigned char* smem) {
  const int tid = otid();
  if (it < 192) {
    const int l = it / 96, rem = it % 96, kc = rem / 6, cc = rem % 6;
    float* sil = (float*)smem;
    __syncthreads();
    if (tid < 192) { const int cnd = tid >> 6, kk = tid & 63, k = kc * 64 + kk; const float cv = cnd == 0 ? P.cctx[k] : P.c[(cnd - 1) * 1024 + k]; sil[tid] = siluf(cv); }
    __syncthreads();
    const int col = cc * NT + tid;
    const float* w = P.wada + ((size_t)l * 1024 + kc * 64) * 3072 + col;
    float a0 = 0.f, a1 = 0.f, a2 = 0.f;
#pragma unroll 8
    for (int kk = 0; kk < 64; ++kk) { const float wv = w[(size_t)kk * 3072]; a0 += sil[kk] * wv; a1 += sil[64 + kk] * wv; a2 += sil[128 + kk] * wv; }
    const float bb = kc == 0 ? P.bada[l * 3072 + col] : 0.f;
    float* mod = WSP(float, OFF_MOD) + (size_t)l * 9216 + col;
    atomicAdd(mod, a0 + bb); atomicAdd(mod + 3072, a1 + bb); atomicAdd(mod + 6144, a2 + bb);
    return;
  }
  it -= 192;
  if (it < 1152) {
    const int hb = tid >> 8, tl = tid & 255, it2 = 2 * it + hb;
    const float* src; bf16_t* dst; int N, tn, tk;
    if (it2 < 1792) { const int l = it2 / 896, r2 = it2 % 896; tn = r2 / 16; tk = r2 % 16; N = 3584; src = P.win + (size_t)l * 1024 * 3584; dst = WSP(bf16_t, OFF_WINT) + (size_t)l * 3584 * 1024; }
    else { const int i2 = it2 - 1792, l = i2 / 256, r2 = i2 % 256; tn = r2 / 16; tk = r2 % 16; N = 1024; src = P.wout + (size_t)l * 1024 * 1024; dst = WSP(bf16_t, OFF_WOUTT) + (size_t)l * 1024 * 1024; }
    float* tile = (float*)smem + hb * 4160;
    float rg[16];
#pragma unroll
    for (int u = 0; u < 16; ++u) { const int e = tl + 256 * u, kk = e >> 6, nn = e & 63; rg[u] = src[(size_t)(tk * 64 + kk) * N + tn * 64 + nn]; }
    __syncthreads();
#pragma unroll
    for (int u = 0; u < 16; ++u) { const int e = tl + 256 * u, kk = e >> 6, nn = e & 63; tile[kk * 65 + nn] = rg[u]; }
    __syncthreads();
#pragma unroll
    for (int u = 0; u < 8; ++u) { const int e = tl + 256 * u, nn = e >> 5, k2 = (e & 31) * 2;
      *(unsigned*)(dst + (size_t)(tn * 64 + nn) * 1024 + tk * 64 + k2) = pk(tile[k2 * 65 + nn], tile[(k2 + 1) * 65 + nn]); }
    return;
  }
  it -= 1152;
  if (it < 192) {
    for (int u = 0; u < 4096 / NT; ++u) {
      const int e = it * 4096 + u * NT + tid;
      if (e < 131072) {
        const int ci = e & 127, t = (e >> 7) & 255, b = (e >> 15) & 1, l = e >> 16;
        WSP(bf16_t, OFF_KA_LAT)[((size_t)(l * 2 + b) * 4352 + t) * 128 + ci] = f2bf(P.cgk[((size_t)(b * 2 + l) * 256 + t) * 128 + ci]);
      } else if (e < 262144) {
        const int e2 = e - 131072, t = e2 & 255, d = (e2 >> 8) & 63, kvh = (e2 >> 14) & 1, b = (e2 >> 15) & 1, l = e2 >> 16;
        WSP(bf16_t, OFF_VTA_LAT)[(((size_t)(l * 2 + b) * 2 + kvh) * 64 + d) * 4352 + t] = f2bf(P.cgv[((size_t)(b * 2 + l) * 256 + t) * 128 + kvh * 64 + d]);
      } else if (e < 524288) {
        const int e2 = e - 262144, ci = e2 & 255, t = (e2 >> 8) & 255, b = (e2 >> 16) & 1, l = e2 >> 17;
        WSP(bf16_t, OFF_KD_LAT)[((size_t)(l * 2 + b) * 4352 + t) * 256 + ci] = f2bf(P.cdk[((size_t)(b * 2 + l) * 256 + t) * 256 + ci]);
      } else {
        const int e2 = e - 524288, t = e2 & 255, d = (e2 >> 8) & 63, h = (e2 >> 14) & 3, b = (e2 >> 16) & 1, l = e2 >> 17;
        WSP(bf16_t, OFF_VTD_LAT)[(((size_t)(l * 2 + b) * 4 + h) * 64 + d) * 4352 + t] = f2bf(P.cdv[((size_t)(b * 2 + l) * 256 + t) * 256 + h * 64 + d]);
      }
    }
    return;
  }
  float* lbs = WSP(float, OFF_LBS);
  for (int e = tid; e < 512; e += NT) {
    const int dir = e >> 8, ci = e & 255;
    const float a0 = P.hlb[(0 * 2 + dir) * 256 + ci], a1 = P.hlb[(1 * 2 + dir) * 256 + ci], mx = fmaxf(a0, a1);
    const float e0 = expf(a0 - mx), e1 = expf(a1 - mx);
    lbs[(0 * 2 + dir) * 256 + ci] = 0.f; lbs[(1 * 2 + dir) * 256 + ci] = e1 / (e0 + e1);
  }
  if (tid < 2) {
    const int l = tid; float s1 = 0.f, s2 = 0.f;
    for (int i = 0; i < 32; ++i) { s1 += P.dlam[(l * 4 + 0) * 32 + i] * P.dlam[(l * 4 + 1) * 32 + i]; s2 += P.dlam[(l * 4 + 2) * 32 + i] * P.dlam[(l * 4 + 3) * 32 + i]; }
    const float li = 0.8f - 0.6f * expf(-0.3f * (float)l);
    WSP(float, OFF_LAM)[l] = expf(s1) - expf(s2) + li;
  }
  for (int e = tid; e < 1024; e += NT) { const int pos = e >> 4, i = e & 15; const float inv = powf(10000.f, -(float)i / 16.f), ang = (float)pos * inv; WSP(float, OFF_T64C)[e] = cosf(ang); WSP(float, OFF_T64S)[e] = sinf(ang); }
  for (int e = tid; e < 512; e += NT) { const int pos = e >> 3, i = e & 7; const float inv = powf(10000.f, -(float)i / 8.f), ang = (float)pos * inv; WSP(float, OFF_T32C)[e] = cosf(ang); WSP(float, OFF_T32S)[e] = sinf(ang); }
}

DI void p0b(const Params& P) {
  const int gtid = blockIdx.x * NT + threadIdx.x, gsz = gridDim.x * NT;
  const float* mod = WSP(float, OFF_MOD);
  bf16_t* H = WSP(bf16_t, OFF_H);
  for (int e = gtid; e < 16384 * 128; e += gsz) {
    const int token = e >> 7, c8 = (e & 127) * 8;
    const int cond = token < 8192 ? 0 : 1 + ((token - 8192) >> 12);
    const float* xr = (token < 8192 ? P.xp + (size_t)token * 1024 : P.xs + (size_t)(token - 8192) * 1024) + c8;
    const float* sh = mod + cond * 3072 + c8; const float* sc = sh + 1024;
    const f32x4 x0 = *(const f32x4*)xr, x1 = *(const f32x4*)(xr + 4);
    const f32x4 h0 = x0 * (*(const f32x4*)sc + 1.f) + *(const f32x4*)sh, h1 = x1 * (*(const f32x4*)(sc + 4) + 1.f) + *(const f32x4*)(sh + 4);
    u32x4 o; o.x = pk(h0[0], h0[1]); o.y = pk(h0[2], h0[3]); o.z = pk(h1[0], h1[1]); o.w = pk(h1[2], h1[3]);
    *(u32x4*)(H + (size_t)token * 1024 + c8) = o;
  }
}

template <int MT>
DI void gemm_tile(const bf16_t* __restrict__ A, const bf16_t* __restrict__ Bt, int K, int row0, int col0, unsigned char* smem, f32x4 (&acc)[MT][4]) {
  const int tid = otid(), lane = tid & 63, w = tid >> 6, wm = w >> 2, wn = w & 3, r = lane & 15, quad = lane >> 4;
  const bf16_t* Ag = A + (size_t)row0 * K; const bf16_t* Bg = Bt + (size_t)col0 * K;
#pragma unroll
  for (int mt = 0; mt < MT; ++mt)
#pragma unroll
    for (int nt = 0; nt < 4; ++nt) acc[mt][nt] = (f32x4){0.f, 0.f, 0.f, 0.f};
  const int srow = tid >> 3, sk = ((tid & 7) ^ (srow & 7)) * 8;
  const bf16_t* ga = Ag + (size_t)srow * K + sk; const bf16_t* gb = Bg + (size_t)srow * K + sk;
  const size_t pstep = (size_t)64 * K;
  const int nk = K / 64;
#define GT_DMA(st, k0) do { LAS unsigned char* lb_ = (LAS unsigned char*)smem + (st) * 65536 + w * 1024; \
    _Pragma("unroll") for (int i = 0; i < MT / 2; ++i) __builtin_amdgcn_global_load_lds((const unsigned*)(ga + i * pstep + (k0)), (LAS unsigned*)(lb_ + i * 8192), 16, 0, 0); \
    _Pragma("unroll") for (int i = 0; i < 4; ++i) __builtin_amdgcn_global_load_lds((const unsigned*)(gb + i * pstep + (k0)), (LAS unsigned*)(lb_ + 32768 + i * 8192), 16, 0, 0); } while (0)
  __syncthreads();
  GT_DMA(0, 0);
  asm volatile("s_waitcnt vmcnt(0)" ::: "memory");
  __syncthreads();
  const int sw = r & 7;
  for (int kt = 0; kt < nk; ++kt) {
    const int cur = kt & 1;
    if (kt + 1 < nk) GT_DMA(cur ^ 1, (kt + 1) * 64);
    const unsigned char* As = smem + cur * 65536; const unsigned char* Bs = As + 32768;
#pragma unroll
    for (int ks = 0; ks < 2; ++ks) {
      s16x8 af[MT], bfr[4];
      const int co = ((4 * ks + quad) ^ sw) * 16;
#pragma unroll
      for (int mt = 0; mt < MT; ++mt) af[mt] = *(const s16x8*)(As + (wm * 16 * MT + 16 * mt + r) * 128 + co);
#pragma unroll
      for (int nt = 0; nt < 4; ++nt) bfr[nt] = *(const s16x8*)(Bs + (wn * 64 + 16 * nt + r) * 128 + co);
#pragma unroll
      for (int mt = 0; mt < MT; ++mt)
#pragma unroll
        for (int nt = 0; nt < 4; ++nt) acc[mt][nt] = MFMA(bfr[nt], af[mt], acc[mt][nt]);
    }
    asm volatile("s_waitcnt vmcnt(0)" ::: "memory");
    __syncthreads();
  }
#undef GT_DMA
}

constexpr int LDT = 72;
DI void stage_row4(bf16_t* T, int mt, int nt, int lane, u32x2 v) { *(u32x2*)(T + (16 * (mt & 3) + (lane & 15)) * LDT + 16 * nt + 4 * (lane >> 4)) = v; }
DI void flush_rows(const bf16_t* T, bf16_t* __restrict__ g  , size_t stride, int lane) {
  asm volatile("s_waitcnt lgkmcnt(0)" ::: "memory");
#pragma unroll
  for (int u = 0; u < 8; ++u) { const int ch = u * 64 + lane, row = ch >> 3, k = ch & 7; *(u32x4*)(g + (size_t)row * stride + k * 8) = *(const u32x4*)(T + row * LDT + k * 8); }
  asm volatile("" ::: "memory");
}
#define FLUSH_IF(mt, gbase, stride) do { if (((mt) & 3) == 3) flush_rows(T, (gbase) + (size_t)(64 * ((mt) >> 2)) * (stride), (stride), lane); } while (0)

template <int MT>
DI void inproj_epi(const Params& P, int l, f32x4 (&acc)[MT][4], int rowb, int colb, int lane, unsigned char* smem_w) {
  bf16_t* T = (bf16_t*)smem_w;
  const int c = lane & 15, quad = lane >> 4;
  const bool lat = rowb >= 8192;
  bf16_t* mix = WSP(bf16_t, OFF_MIX);
  if (colb < 640) {
    const bool isq = colb < 512;
    const float* gain = (isq ? P.qn : P.kn) + l * 64;
    f32x4 gn[4];
#pragma unroll
    for (int nt = 0; nt < 4; ++nt) gn[nt] = *(const f32x4*)(gain + 16 * nt + 4 * quad);
#pragma unroll
    for (int mt = 0; mt < MT; ++mt) {
      const int token = rowb + 16 * mt + c;
      float ss = 0.f;
#pragma unroll
      for (int nt = 0; nt < 4; ++nt)
#pragma unroll
        for (int j = 0; j < 4; ++j) ss += acc[mt][nt][j] * acc[mt][nt][j];
      ss += __shfl_xor(ss, 16); ss += __shfl_xor(ss, 32);
      const float rinv = rsqrtf(ss * (1.f / 64.f) + 1e-6f);
      f32x4 v[4];
#pragma unroll
      for (int nt = 0; nt < 4; ++nt) v[nt] = acc[mt][nt] * rinv * gn[nt];
      const int n = (token - 8192) & 4095, bb = (token - 8192) >> 12;
      if (lat) {
        const int prow = n >> 6, pcol = n & 63;
        const f32x4 cr = *(const f32x4*)(WSP(float, OFF_T64C) + prow * 16 + 4 * quad), sr = *(const f32x4*)(WSP(float, OFF_T64S) + prow * 16 + 4 * quad);
        const f32x4 cc = *(const f32x4*)(WSP(float, OFF_T64C) + pcol * 16 + 4 * quad), sc = *(const f32x4*)(WSP(float, OFF_T64S) + pcol * 16 + 4 * quad);
        const f32x4 a0 = v[0] * cr - v[1] * sr, a1 = v[1] * cr + v[0] * sr, a2 = v[2] * cc - v[3] * sc, a3 = v[3] * cc + v[2] * sc;
        v[0] = a0; v[1] = a1; v[2] = a2; v[3] = a3;
      }
#pragma unroll
      for (int nt = 0; nt < 4; ++nt) stage_row4(T, mt, nt, lane, pk4(v[nt]));
      if (isq) FLUSH_IF(mt, WSP(bf16_t, OFF_QA) + (size_t)rowb * 512 + colb, 512);
      else {
        const int kc = colb - 512;
        if (!lat) {
          const int b = token >> 8, s = token & 255;
          float* o = P.out + OUT_GK + ((size_t)(b * 2 + l) * 256 + s) * 128 + kc + 4 * quad;
#pragma unroll
          for (int nt = 0; nt < 4; ++nt) *(f32x4*)(o + 16 * nt) = v[nt];
          FLUSH_IF(mt, WSP(bf16_t, OFF_KA_CTX) + (size_t)rowb * 128 + kc, 128);
        } else FLUSH_IF(mt, WSP(bf16_t, OFF_KA_LAT) + ((size_t)(l * 2 + ((rowb - 8192) >> 12)) * 4352 + 256 + ((rowb - 8192) & 4095)) * 128 + kc, 128);
      }
    }
  } else if (colb < 768) {
    const int vc = colb - 640, kvh = vc >> 6;
#pragma unroll
    for (int mt = 0; mt < MT; ++mt) {
      const int token = rowb + 16 * mt + c;
      bf16_t* dst; size_t dstr;
      if (!lat) {
        const int b = token >> 8, s = token & 255;
        float* o = P.out + OUT_GV + ((size_t)(b * 2 + l) * 256 + s) * 128 + vc + 4 * quad;
#pragma unroll
        for (int nt = 0; nt < 4; ++nt) *(f32x4*)(o + 16 * nt) = acc[mt][nt];
        dst = WSP(bf16_t, OFF_VTA_CTX) + ((size_t)(b * 2 + kvh) * 64) * 256 + s; dstr = 256;
      } else {
        const int n = (token - 8192) & 4095, bb = (token - 8192) >> 12;
        dst = WSP(bf16_t, OFF_VTA_LAT) + (((size_t)(l * 2 + bb) * 2 + kvh) * 64) * 4352 + 256 + n; dstr = 4352;
      }
#pragma unroll
      for (int nt = 0; nt < 4; ++nt)
#pragma unroll
        for (int j = 0; j < 4; ++j) dst[(size_t)(16 * nt + 4 * quad + j) * dstr] = f2bf(acc[mt][nt][j]);
    }
  } else if (colb < 1280 || (colb >= 2048 && colb < 2304) || colb >= 3328) {
    const int mc = colb < 1280 ? colb - 768 : (colb < 2304 ? 512 + colb - 2048 : 768 + colb - 3328);
#pragma unroll
    for (int mt = 0; mt < MT; ++mt) {
#pragma unroll
      for (int nt = 0; nt < 4; ++nt) stage_row4(T, mt, nt, lane, pk4(silu4(acc[mt][nt])));
      FLUSH_IF(mt, mix + (size_t)rowb * 1024 + mc, 1024);
    }
  } else if (colb < 1792) {
    const bool isq = colb < 1536;
#pragma unroll
    for (int mt = 0; mt < MT; ++mt) {
      const int token = rowb + 16 * mt + c;
      const int n = (token - 8192) & 4095, bb = (token - 8192) >> 12;
      f32x4 v[4];
#pragma unroll
      for (int nt = 0; nt < 4; ++nt) v[nt] = acc[mt][nt];
      if (lat) {
        const int prow = n >> 6, pcol = n & 63;
#pragma unroll
        for (int nt = 0; nt < 4; ++nt) {
          const int pos = (nt & 1) ? pcol : prow;
          const f32x4 cs = *(const f32x4*)(WSP(float, OFF_T32C) + pos * 8 + (quad & 1) * 4), sn = *(const f32x4*)(WSP(float, OFF_T32S) + pos * 8 + (quad & 1) * 4);
          f32x4 pr;
#pragma unroll
          for (int j = 0; j < 4; ++j) pr[j] = __shfl_xor(v[nt][j], 32);
          v[nt] = quad < 2 ? v[nt] * cs - pr * sn : v[nt] * cs + pr * sn;
        }
      }
#pragma unroll
      for (int nt = 0; nt < 4; ++nt) stage_row4(T, mt, nt, lane, pk4(v[nt]));
      if (isq) FLUSH_IF(mt, WSP(bf16_t, OFF_QD) + (size_t)rowb * 256 + (colb - 1280), 256);
      else {
        const int kc = colb - 1536;
        if (!lat) {
          const int b = token >> 8, s = token & 255;
          float* o = P.out + OUT_DK + ((size_t)(b * 2 + l) * 256 + s) * 256 + kc + 4 * quad;
#pragma unroll
          for (int nt = 0; nt < 4; ++nt) *(f32x4*)(o + 16 * nt) = v[nt];
          FLUSH_IF(mt, WSP(bf16_t, OFF_KD_CTX) + (size_t)rowb * 256 + kc, 256);
        } else FLUSH_IF(mt, WSP(bf16_t, OFF_KD_LAT) + ((size_t)(l * 2 + ((rowb - 8192) >> 12)) * 4352 + 256 + ((rowb - 8192) & 4095)) * 256 + kc, 256);
      }
    }
  } else if (colb < 2048) {
    const int vc = colb - 1792, h = vc >> 6;
#pragma unroll
    for (int mt = 0; mt < MT; ++mt) {
      const int token = rowb + 16 * mt + c;
      bf16_t* dst; size_t dstr;
      if (!lat) {
        const int b = token >> 8, s = token & 255;
        float* o = P.out + OUT_DV + ((size_t)(b * 2 + l) * 256 + s) * 256 + vc + 4 * quad;
#pragma unroll
        for (int nt = 0; nt < 4; ++nt) *(f32x4*)(o + 16 * nt) = acc[mt][nt];
        dst = WSP(bf16_t, OFF_VTD_CTX) + ((size_t)(b * 4 + h) * 64) * 256 + s; dstr = 256;
      } else {
        const int n = (token - 8192) & 4095, bb = (token - 8192) >> 12;
        dst = WSP(bf16_t, OFF_VTD_LAT) + (((size_t)(l * 2 + bb) * 4 + h) * 64) * 4352 + 256 + n; dstr = 4352;
      }
#pragma unroll
      for (int nt = 0; nt < 4; ++nt)
#pragma unroll
        for (int j = 0; j < 4; ++j) dst[(size_t)(16 * nt + 4 * quad + j) * dstr] = f2bf(acc[mt][nt][j]);
    }
  } else if (colb < 2560) {
#pragma unroll
    for (int mt = 0; mt < MT; ++mt) {
#pragma unroll
      for (int nt = 0; nt < 4; ++nt) stage_row4(T, mt, nt, lane, pk4(silu4(acc[mt][nt])));
      FLUSH_IF(mt, WSP(bf16_t, OFF_HQ) + (size_t)rowb * 256 + (colb - 2304), 256);
    }
  } else if (colb < 3072) {
    const int dir = colb < 2816 ? 0 : 1, cc0 = colb - (dir ? 2816 : 2560);
    float* G = WSP(float, dir ? OFF_GB : OFF_GF);
    f32x4 lb[4];
#pragma unroll
    for (int nt = 0; nt < 4; ++nt) lb[nt] = *(const f32x4*)(WSP(float, OFF_LBS) + (l * 2 + dir) * 256 + cc0 + 16 * nt + 4 * quad);
#pragma unroll
    for (int mt = 0; mt < MT; ++mt) {
      const int token = rowb + 16 * mt + c;
      float* dst = G + (size_t)token * 256 + cc0 + 4 * quad;
#pragma unroll
      for (int nt = 0; nt < 4; ++nt) {
        f32x4 g;
#pragma unroll
        for (int j = 0; j < 4; ++j) { const float f = lb[nt][j] + (1.f - lb[nt][j]) * sigmf(acc[mt][nt][j]); g[j] = logf(fmaxf(f, 1e-6f)); }
        *(f32x4*)(dst + 16 * nt) = g;
      }
    }
  } else {
#pragma unroll
    for (int mt = 0; mt < MT; ++mt) {
#pragma unroll
      for (int nt = 0; nt < 4; ++nt) stage_row4(T, mt, nt, lane, pk4(acc[mt][nt]));
      FLUSH_IF(mt, WSP(bf16_t, OFF_HV) + (size_t)rowb * 256 + (colb - 3072), 256);
    }
  }
}

DI void phase_inproj(const Params& P, int l, unsigned char* smem) {
  const bf16_t* A = WSP(bf16_t, OFF_H); const bf16_t* Bt = WSP(bf16_t, OFF_WINT) + (size_t)l * 3584 * 1024;
  const int xcd = blockIdx.x & 7, nbx = gridDim.x >> 3;
  for (int j = blockIdx.x >> 3; j < 96; j += nbx) {
    const int tid = otid(), lane = tid & 63, w = tid >> 6, wm = w >> 2, wn = w & 3;
    const int q = j & 31, pm = 8 * xcd + (q >> 2), pn = 4 * (j >> 5) + (q & 3);
    f32x4 acc[8][4];
    gemm_tile<8>(A, Bt, 1024, pm * 256, pn * 256, smem, acc);
    inproj_epi<8>(P, l, acc, pm * 256 + wm * 128, pn * 256 + wn * 64, lane, smem + w * 9216);
  }
  for (int j = blockIdx.x >> 3; j < 32; j += nbx) {
    const int tid = otid(), lane = tid & 63, w = tid >> 6, wm = w >> 2, wn = w & 3;
    const int pm = 8 * xcd + (j >> 2), pn = 12 + ((j >> 1) & 1), hm = j & 1;
    f32x4 acc[4][4];
    gemm_tile<4>(A, Bt, 1024, pm * 256 + hm * 128, pn * 256, smem, acc);
    inproj_epi<4>(P, l, acc, pm * 256 + hm * 128 + wm * 64, pn * 256 + wn * 64, lane, smem + w * 9216);
  }
}

DI void phase_outproj(const Params& P, int l, unsigned char* smem) {
  const bf16_t* A = WSP(bf16_t, OFF_MIX); const bf16_t* Bt = WSP(bf16_t, OFF_WOUTT) + (size_t)l * 1024 * 1024;
  const float* mod = WSP(float, OFF_MOD) + (size_t)l * 9216;
  const float alpha = 1.41421356237f;
  const int xcd = blockIdx.x & 7, nbx = gridDim.x >> 3;
  for (int j = blockIdx.x >> 3; j < 32; j += nbx) {
    const int tid = otid(), lane = tid & 63, w = tid >> 6, wm = w >> 2, wn = w & 3, c = lane & 15, quad = lane >> 4;
    const int pm = 8 * xcd + (j >> 2), pn = j & 3;
    f32x4 acc[8][4];
    gemm_tile<8>(A, Bt, 1024, pm * 256, pn * 256, smem, acc);
    const int rowb = pm * 256 + wm * 128, colb = pn * 256 + wn * 64;
#pragma unroll
    for (int mt = 0; mt < 8; ++mt) {
      const int token = rowb + 16 * mt + c;
      const int cond = token < 8192 ? 0 : 1 + ((token - 8192) >> 12);
      const float* xo = l == 0 ? (token < 8192 ? P.xp + (size_t)token * 1024 : P.xs + (size_t)(token - 8192) * 1024) : P.out + (size_t)token * 1024;
      bf16_t* T = (bf16_t*)(smem + w * 9216);
#pragma unroll
      for (int nt = 0; nt < 4; ++nt) {
        const int col = colb + 16 * nt + 4 * quad;
        const f32x4 g = *(const f32x4*)(mod + cond * 3072 + 2048 + col), xv = *(const f32x4*)(xo + col);
        stage_row4(T, mt, nt, lane, pk4(xv * alpha + g * acc[mt][nt]));
      }
      FLUSH_IF(mt, WSP(bf16_t, OFF_GF) + (size_t)rowb * 1024 + colb, 1024);
    }
  }
}

DI void phase_ln(const Params& P, int l, int dry = 0) {
  const int lane = threadIdx.x & 63, gw = blockIdx.x * (NT / 64) + (threadIdx.x >> 6), nw = gridDim.x * (NT / 64);
  const float* g = P.lng + l * 1024; const float* b = P.lnb + l * 1024;
  const float* mod1 = WSP(float, OFF_MOD) + 9216;
  constexpr int R = 4;
  for (int row0 = gw; row0 < 16384; row0 += nw * R) {
    f32x4 v[R][4]; float s[R], q[R];
#pragma unroll
    for (int rr = 0; rr < R; ++rr) {
      const int row = row0 + rr * nw;
      if (row < 16384) {
        const bf16_t* vp = WSP(bf16_t, OFF_GF) + (size_t)row * 1024;
#pragma unroll
        for (int i = 0; i < 4; ++i) v[rr][i] = unpk4(*(const u32x2*)(vp + i * 256 + lane * 4));
      }
    }
#pragma unroll
    for (int rr = 0; rr < R; ++rr) {
      const int row = row0 + rr * nw;
      if (row >= 16384) continue;
      float* y = P.out + (size_t)row * 1024;
      s[rr] = 0.f;
#pragma unroll
      for (int i = 0; i < 4; ++i) s[rr] += (v[rr][i][0] + v[rr][i][1]) + (v[rr][i][2] + v[rr][i][3]);
#pragma unroll
      for (int o = 1; o < 64; o <<= 1) s[rr] += __shfl_xor(s[rr], o);
      const float mu = s[rr] * (1.f / 1024.f); q[rr] = 0.f;
#pragma unroll
      for (int i = 0; i < 4; ++i) { v[rr][i] = v[rr][i] - mu; q[rr] += (v[rr][i][0] * v[rr][i][0] + v[rr][i][1] * v[rr][i][1]) + (v[rr][i][2] * v[rr][i][2] + v[rr][i][3] * v[rr][i][3]); }
#pragma unroll
      for (int o = 1; o < 64; o <<= 1) q[rr] += __shfl_xor(q[rr], o);
      const float rstd = rsqrtf(q[rr] * (1.f / 1024.f) + 1e-5f);
      const int cond = row < 8192 ? 0 : 1 + ((row - 8192) >> 12);
#pragma unroll
      for (int i = 0; i < 4; ++i) {
        const int col = i * 256 + lane * 4;
        const f32x4 o = v[rr][i] * rstd * *(const f32x4*)(g + col) + *(const f32x4*)(b + col);
        if (!dry) *(f32x4*)(y + col) = o;
        if (l == 0 && !dry) {
          const f32x4 h = o * (*(const f32x4*)(mod1 + cond * 3072 + 1024 + col) + 1.f) + *(const f32x4*)(mod1 + cond * 3072 + col);
          *(u32x2*)(WSP(bf16_t, OFF_H) + (size_t)row * 1024 + col) = pk4(h);
        }
      }
    }
  }
}

DI s16x8 scale8(s16x8 x, float sc) {
  const u32x4 u = __builtin_bit_cast(u32x4, x); u32x4 o;
  o.x = pk(bflo(u.x) * sc, bfhi(u.x) * sc); o.y = pk(bflo(u.y) * sc, bfhi(u.y) * sc); o.z = pk(bflo(u.z) * sc, bfhi(u.z) * sc); o.w = pk(bflo(u.w) * sc, bfhi(u.w) * sc);
  return __builtin_bit_cast(s16x8, o);
}
constexpr int LDV = 144;
constexpr int LDK = 80;
template <int MODE>
DI void attn_item(const Params& P, int l, const bf16_t* __restrict__ Qp  , int qstride,
                  const bf16_t* __restrict__ Kp  , int kstride, const bf16_t* __restrict__ VTp  , int T,
                  bf16_t* __restrict__ mixp  , unsigned char* smem, int dry = 0) {
  const int tid = otid(), lane = tid & 63, w = tid >> 6, r = lane & 15, quad = lane >> 4;
  constexpr int QW = MODE == 0 ? 32 : 16;
  const float sl2 = (MODE == 0 ? 0.125f : 0.17677669529663687f) * 1.4426950408889634f;
  s16x8 qf[2][2];
  if (MODE == 0) {
#pragma unroll
    for (int qt = 0; qt < 2; ++qt)
#pragma unroll
      for (int ks = 0; ks < 2; ++ks) qf[qt][ks] = scale8(*(const s16x8*)(Qp + (size_t)(w * QW + qt * 16 + r) * qstride + 32 * ks + 8 * quad), sl2);
  } else {
#pragma unroll
    for (int ks = 0; ks < 2; ++ks) { qf[0][ks] = scale8(*(const s16x8*)(Qp + (size_t)(w * QW + r) * qstride + 32 * ks + 8 * quad), sl2); qf[1][ks] = qf[0][ks]; }
  }
  float mref[2] = {0.f, 0.f};
  f32x4 lsT[2] = {{0.f, 0.f, 0.f, 0.f}, {0.f, 0.f, 0.f, 0.f}};
  const s16x8 ones = {0x3F80, 0x3F80, 0x3F80, 0x3F80, 0x3F80, 0x3F80, 0x3F80, 0x3F80};
  f32x4 oT[2][4];
#pragma unroll
  for (int p = 0; p < 2; ++p)
#pragma unroll
    for (int mt = 0; mt < 4; ++mt) oT[p][mt] = (f32x4){0.f, 0.f, 0.f, 0.f};
  unsigned char* Kb0 = smem;
  bf16_t* Vs0 = (bf16_t*)(smem + 32768);
  const int srow = tid >> 3, skc = ((tid & 7) ^ (srow & 7)) * 8;
  const int vrow = tid >> 4, vc8 = (tid & 15) * 8;
  const int vm = (tid & 3), vg = (vc8 & ~31);
  const int vp0 = vg + 8 * ((2 * vm) & 3) + 4 * (vm >> 1), vp1 = vg + 8 * ((2 * vm + 1) & 3) + 4 * (vm >> 1);
  u32x4 rv[2];
  const int nstage = T / 128;
#define AK_DMA(st_, buf_) do { LAS unsigned char* lb_ = (LAS unsigned char*)smem + (buf_) * 16384 + w * 1024; _Pragma("unroll") for (int i = 0; i < 2; ++i) \
    __builtin_amdgcn_global_load_lds((const unsigned*)(Kp + (size_t)((st_) * 128 + 64 * i + srow) * kstride + skc), (LAS unsigned*)(lb_ + i * 8192), 16, 0, 0); } while (0)
  __syncthreads();
  AK_DMA(0, 0);
#pragma unroll
  for (int i = 0; i < 2; ++i) rv[i] = *(const u32x4*)(VTp + (size_t)(32 * i + vrow) * T + vc8);
#pragma unroll
  for (int i = 0; i < 2; ++i) { *(u32x2*)(Vs0 + (32 * i + vrow) * LDV + vp0) = (u32x2){rv[i].x, rv[i].y}; *(u32x2*)(Vs0 + (32 * i + vrow) * LDV + vp1) = (u32x2){rv[i].z, rv[i].w}; }
  asm volatile("s_waitcnt vmcnt(0)" ::: "memory");
  __syncthreads();
  for (int st = 0; st < nstage; ++st) {
    if (st + 1 < nstage) {
      AK_DMA(st + 1, (st + 1) & 1);
      const int key0 = (st + 1) * 128;
#pragma unroll
      for (int i = 0; i < 2; ++i) rv[i] = *(const u32x4*)(VTp + (size_t)(32 * i + vrow) * T + key0 + vc8);
    }
    f32x4 sT[2][2][4];
#pragma unroll
    for (int hk = 0; hk < 2; ++hk) {
      const unsigned char* Ks = Kb0 + (st & 1) * 16384 + hk * 8192;
      s16x8 kf[4][2];
#pragma unroll
      for (int mt = 0; mt < 4; ++mt)
#pragma unroll
        for (int ks = 0; ks < 2; ++ks) kf[mt][ks] = *(const s16x8*)(Ks + (16 * mt + r) * 128 + (((4 * ks + quad) ^ (r & 7)) * 16));
      const f32x4 z0 = {-mref[0], -mref[0], -mref[0], -mref[0]}, z1 = {-mref[1], -mref[1], -mref[1], -mref[1]};
      if (MODE == 0) {
#pragma unroll
        for (int mt = 0; mt < 4; ++mt) { sT[hk][0][mt] = MFMA(kf[mt][0], qf[0][0], z0); sT[hk][1][mt] = MFMA(kf[mt][0], qf[1][0], z1); }
#pragma unroll
        for (int mt = 0; mt < 4; ++mt) { sT[hk][0][mt] = MFMA(kf[mt][1], qf[0][1], sT[hk][0][mt]); sT[hk][1][mt] = MFMA(kf[mt][1], qf[1][1], sT[hk][1][mt]); }
      } else {
#pragma unroll
        for (int mt = 0; mt < 4; ++mt) { sT[hk][0][mt] = MFMA(kf[mt][0], qf[0][0], z0); sT[hk][1][mt] = MFMA(kf[mt][1], qf[0][1], z1); }
      }
    }
#pragma unroll
   for (int hk = 0; hk < 2; ++hk) {
    const int kt = 2 * st + hk;
    const bf16_t* Vs = Vs0 + (st & 1) * 64 * LDV + hk * 64;
    s16x8 vf[4][2];
#pragma unroll
    for (int mt = 0; mt < 4; ++mt)
#pragma unroll
      for (int k2 = 0; k2 < 2; ++k2) {
        vf[mt][k2] = *(const s16x8*)(Vs + (16 * mt + r) * LDV + 32 * k2 + 8 * quad);
      }
    __builtin_amdgcn_sched_barrier(0);
    s16x8 pb[2][2];
#pragma unroll
    for (int p = 0; p < 2; ++p) {
      f32x4 pv[4];
      bool redo = (kt == 0);
      for (;;) {
        if (redo) {
          float mx = -1e30f;
#pragma unroll
          for (int mt = 0; mt < 4; ++mt)
#pragma unroll
            for (int j = 0; j < 4; ++j) mx = fmaxf(mx, sT[hk][p][mt][j]);
          mx = fmaxf(mx, __shfl_xor(mx, 16)); mx = fmaxf(mx, __shfl_xor(mx, 32));
          const float alpha = kt == 0 ? 0.f : __builtin_amdgcn_exp2f(-mx);
          mref[p] += mx; lsT[p] = lsT[p] * alpha;
#pragma unroll
          for (int mt = 0; mt < 4; ++mt) { oT[p][mt] = oT[p][mt] * alpha; sT[hk][p][mt] = sT[hk][p][mt] - mx; }
          if (hk == 0) {
#pragma unroll
            for (int mt = 0; mt < 4; ++mt) sT[1][p][mt] = sT[1][p][mt] - mx;
          }
        }
        if (!redo) {
          float mg = -1e30f;
#pragma unroll
          for (int mt = 0; mt < 4; ++mt)
#pragma unroll
            for (int j = 0; j < 4; ++j) mg = fmaxf(mg, sT[hk][p][mt][j]);
          if (__builtin_amdgcn_ballot_w64(!(mg < 20.f)) != 0ull) { redo = true; continue; }
        }
#pragma unroll
        for (int mt = 0; mt < 4; ++mt)
#pragma unroll
          for (int j = 0; j < 4; ++j) pv[mt][j] = __builtin_amdgcn_exp2f(sT[hk][p][mt][j]);
        break;
      }
#pragma unroll
      for (int k2 = 0; k2 < 2; ++k2) {
        u32x4 u; u.x = pk(pv[2 * k2][0], pv[2 * k2][1]); u.y = pk(pv[2 * k2][2], pv[2 * k2][3]);
        u.z = pk(pv[2 * k2 + 1][0], pv[2 * k2 + 1][1]); u.w = pk(pv[2 * k2 + 1][2], pv[2 * k2 + 1][3]);
        pb[p][k2] = __builtin_bit_cast(s16x8, u);
      }
    }
#pragma unroll
    for (int mt = 0; mt < 4; ++mt)
#pragma unroll
      for (int k2 = 0; k2 < 2; ++k2) {
        oT[0][mt] = MFMA(vf[mt][k2], pb[0][k2], oT[0][mt]);
        oT[1][mt] = MFMA(vf[mt][k2], pb[1][k2], oT[1][mt]);
      }
#pragma unroll
    for (int k2 = 0; k2 < 2; ++k2) { lsT[0] = MFMA(ones, pb[0][k2], lsT[0]); lsT[1] = MFMA(ones, pb[1][k2], lsT[1]); }
   }
    if (st + 1 < nstage) {
      bf16_t* Vd = Vs0 + ((st + 1) & 1) * 64 * LDV;
#pragma unroll
      for (int i = 0; i < 2; ++i) { *(u32x2*)(Vd + (32 * i + vrow) * LDV + vp0) = (u32x2){rv[i].x, rv[i].y}; *(u32x2*)(Vd + (32 * i + vrow) * LDV + vp1) = (u32x2){rv[i].z, rv[i].w}; }
    }
    asm volatile("s_waitcnt vmcnt(0)" ::: "memory");
    __syncthreads();
  }
#undef AK_DMA
  float inv[2];
#pragma unroll
  for (int p = 0; p < 2; ++p) inv[p] = 1.f / lsT[p][0];
  if (dry) return;
  if (MODE == 0) {
#pragma unroll
    for (int qt = 0; qt < 2; ++qt) {
      bf16_t* dst = mixp + (size_t)(w * QW + qt * 16 + r) * 1024 + 4 * quad;
#pragma unroll
      for (int mt = 0; mt < 4; ++mt) {
        const f32x4 g = unpk4(*(const u32x2*)(dst + 16 * mt));
        *(u32x2*)(dst + 16 * mt) = pk4(oT[qt][mt] * inv[qt] * g);
      }
    }
  } else {
    const float lam = WSP(float, OFF_LAM)[l];
    const float li = 0.8f - 0.6f * expf(-0.3f * (float)l);
    f32x4 o[4]; float ss = 0.f;
#pragma unroll
    for (int mt = 0; mt < 4; ++mt) { o[mt] = oT[0][mt] * inv[0] - oT[1][mt] * (inv[1] * lam); ss += (o[mt][0] * o[mt][0] + o[mt][1] * o[mt][1]) + (o[mt][2] * o[mt][2] + o[mt][3] * o[mt][3]); }
    ss += __shfl_xor(ss, 16); ss += __shfl_xor(ss, 32);
    const float rinv = rsqrtf(ss * (1.f / 64.f) + 1e-6f) * (1.f - li);
    bf16_t* dst = mixp + (size_t)(w * QW + r) * 1024 + 4 * quad;
#pragma unroll
    for (int mt = 0; mt < 4; ++mt) {
      const f32x4 g = unpk4(*(const u32x2*)(dst + 16 * mt));
      const f32x4 sub = *(const f32x4*)(P.dsub + l * 64 + 16 * mt + 4 * quad);
      *(u32x2*)(dst + 16 * mt) = pk4(o[mt] * rinv * sub * g);
    }
  }
}

DI void mm64(const bf16_t* A, const bf16_t* Bt, int w, int lane, f32x4 (&acc)[4]) {
  const int r = lane & 15, quad = lane >> 4;
#pragma unroll
  for (int ks = 0; ks < 2; ++ks) {
    const s16x8 a = *(const s16x8*)(A + (16 * w + r) * LD + 32 * ks + 8 * quad);
#pragma unroll
    for (int nt = 0; nt < 4; ++nt) { const s16x8 b = *(const s16x8*)(Bt + (16 * nt + r) * LD + 32 * ks + 8 * quad); acc[nt] = MFMA(a, b, acc[nt]); }
  }
}

DI void hgrn_gload(const float* __restrict__ garr, int tok0, int h, int dir, float (&gv)[16]) {
  const int tid = otid() & 255, kk = tid & 63, q4 = tid >> 6;
#pragma unroll
  for (int i = 0; i < 16; ++i) { const int t = 16 * q4 + i, token = dir ? tok0 + 63 - t : tok0 + t; gv[i] = garr[(size_t)token * 256 + h * 64 + kk]; }
}
DI void hgrn_gates_pre(float* bt  , const float (&gv)[16], float (&dG)[16], float& glm, float& Mv) {
  const int tid = otid() & 255, kk = tid & 63, q4 = tid >> 6;
  float run = 0.f;
#pragma unroll
  for (int i = 0; i < 16; ++i) { run += gv[i]; dG[i] = run; }
  bt[q4 * 64 + kk] = run;
  __syncthreads();
  const float b0 = bt[kk], b1 = bt[64 + kk], b2 = bt[128 + kk], b3 = bt[192 + kk];
  const float R = q4 == 0 ? 0.f : (q4 == 1 ? b0 : (q4 == 2 ? b0 + b1 : b0 + b1 + b2));
  Mv = b0 + b1; glm = b2 + b3;
#pragma unroll
  for (int i = 0; i < 16; ++i) dG[i] = R + dG[i] - Mv;
}
DI void hgrn_gates(const float* __restrict__ garr, int tok0, int h, int dir, float* bt, float (&gv)[16], float (&dG)[16], float& glm, float& Mv) {
  hgrn_gload(garr, tok0, h, dir, gv);
  hgrn_gates_pre(bt, gv, dG, glm, Mv);
}

DI void hgrn_a_item(const Params& P, int pair, unsigned char* smem0) {
  const int tid0 = otid(), tid = tid0 & 255, lane = tid & 63, w = tid >> 6, kk = tid & 63, q4 = tid >> 6;
  const int it = 2 * pair + (tid0 >> 8); unsigned char* smem = smem0 + (tid0 >> 8) * HALF_LDS;
  const int dir = it & 1, h = (it >> 1) & 3, tc = it >> 3, tok0 = tc * 64;
  bf16_t* KT = (bf16_t*)smem; bf16_t* VT = KT + 64 * LD; float* bt = (float*)(smem + 40960); float* scl = bt + 256;
  __syncthreads();
  float gv[16], dG[16], glm, Mv;
  float vv[16];
  {
    const bf16_t* hv = WSP(bf16_t, OFF_HV);
#pragma unroll
    for (int i = 0; i < 16; ++i) { const int t = 16 * q4 + i, token = dir ? tok0 + 63 - t : tok0 + t; vv[i] = bf2f(hv[(size_t)token * 256 + h * 64 + kk]); }
  }
  hgrn_gates(WSP(float, dir ? OFF_GB : OFF_GF), tok0, h, dir, bt, gv, dG, glm, Mv);
  {
    u32x4 u0, u1; float kh[16];
#pragma unroll
    for (int i = 0; i < 16; ++i) kh[i] = (1.f - __expf(gv[i])) * __expf(fminf(-dG[i], 80.f));
    u0.x = pk(kh[0], kh[1]); u0.y = pk(kh[2], kh[3]); u0.z = pk(kh[4], kh[5]); u0.w = pk(kh[6], kh[7]);
    u1.x = pk(kh[8], kh[9]); u1.y = pk(kh[10], kh[11]); u1.z = pk(kh[12], kh[13]); u1.w = pk(kh[14], kh[15]);
    *(u32x4*)(KT + kk * LD + 16 * q4) = u0; *(u32x4*)(KT + kk * LD + 16 * q4 + 8) = u1;
    if (q4 == 0) { scl[kk] = __expf(glm); WSP(float, OFF_HP)[(size_t)it * 64 + kk] = __expf(glm + Mv); }
    u0.x = pk(vv[0], vv[1]); u0.y = pk(vv[2], vv[3]); u0.z = pk(vv[4], vv[5]); u0.w = pk(vv[6], vv[7]);
    u1.x = pk(vv[8], vv[9]); u1.y = pk(vv[10], vv[11]); u1.z = pk(vv[12], vv[13]); u1.w = pk(vv[14], vv[15]);
    *(u32x4*)(VT + kk * LD + 16 * q4) = u0; *(u32x4*)(VT + kk * LD + 16 * q4 + 8) = u1;
  }
  __syncthreads();
  f32x4 acc[4];
#pragma unroll
  for (int nt = 0; nt < 4; ++nt) acc[nt] = (f32x4){0.f, 0.f, 0.f, 0.f};
  mm64(KT, VT, w, lane, acc);
  float* U = WSP(float, OFF_HS) + (size_t)it * 4096;
  const int c = lane & 15, quad = lane >> 4;
#pragma unroll
  for (int j = 0; j < 4; ++j) {
    const int k = 16 * w + 4 * quad + j; const float s = scl[k];
#pragma unroll
    for (int nt = 0; nt < 4; ++nt) U[k * 64 + 16 * nt + c] = acc[nt][j] * s;
  }
}

DI void hgrn_b_item(const Params& P, int l, int it, unsigned char* smem) {
  const int tid = otid(), g = tid >> 6, e = tid & 63;
  const int sq = it >> 6, b = sq >> 3, h = (sq >> 1) & 3, dir = sq & 1, eg = it & 63, kv = eg * 64 + e, c0 = 128 + b * 64;
  float* HS = WSP(float, OFF_HS); const float* HP = WSP(float, OFF_HP);
  float* gp = (float*)smem; float* gu = gp + 512;
  float U[8], Pd[8];
#pragma unroll
  for (int u = 0; u < 8; ++u) { const int ci = 8 * g + u, tc = dir ? c0 + 63 - ci : c0 + ci; const size_t idx = (size_t)(tc * 4 + h) * 2 + dir; U[u] = HS[idx * 4096 + kv]; Pd[u] = HP[idx * 64 + eg]; }
  float S = P.st[((size_t)((b * 2 + l) * 2 + dir) * 4 + h) * 4096 + kv];
  float Pg = 1.f, Ug = 0.f;
#pragma unroll
  for (int u = 0; u < 8; ++u) { Ug = Pd[u] * Ug + U[u]; Pg *= Pd[u]; }
  __syncthreads();
  gp[g * 64 + e] = Pg; gu[g * 64 + e] = Ug;
  __syncthreads();
  for (int gg = 0; gg < g; ++gg) S = gp[gg * 64 + e] * S + gu[gg * 64 + e];
#pragma unroll
  for (int u = 0; u < 8; ++u) { const int ci = 8 * g + u, tc = dir ? c0 + 63 - ci : c0 + ci; const size_t idx = (size_t)(tc * 4 + h) * 2 + dir; HS[idx * 4096 + kv] = S; S = Pd[u] * S + U[u]; }
}

DI void hgrn_c_item(const Params& P, int l, int pair, unsigned char* smem0, int dry = 0) {
  const int tid0 = otid(), tid = tid0 & 255, lane = tid & 63, w = tid >> 6, kk = tid & 63, q4 = tid >> 6, c = lane & 15, quad = lane >> 4;
  const int it = 2 * pair + (tid0 >> 8); unsigned char* smem = smem0 + (tid0 >> 8) * HALF_LDS;
  const int h = it & 3, tc = it >> 2, tok0 = tc * 64;
  bf16_t* QH = (bf16_t*)smem; bf16_t* KH = QH + 64 * LD; bf16_t* VT = KH + 64 * LD; bf16_t* ST = VT + 64 * LD; bf16_t* AM = KH;
  float* bt = (float*)(smem + 40960); float* em = bt + 256;
  f32x4 ob[4], of[4];
  float qvN[16], vvN[16], gvN[16];
#pragma unroll
  for (int dd = 0; dd < 2; ++dd) {
    const int dir = 1 - dd;
    const size_t idx = (size_t)(tc * 4 + h) * 2 + dir;
    __syncthreads();
    const float* HSb = WSP(float, OFF_HS); const float* HPb = WSP(float, OFF_HP);
    const float* Sp = HSb + idx * 4096;
    const int cq = tc & ~3, pos = dir ? cq + 3 - tc : tc - cq;
    const int kb = tid >> 6, vv0 = tid & 63;
    float sv[16], qv[16], vv[16], gv[16];
    if (dd == 0) {
      const bf16_t* hq = WSP(bf16_t, OFF_HQ); const bf16_t* hv = WSP(bf16_t, OFF_HV);
#pragma unroll
      for (int i = 0; i < 16; ++i) {
        const int t = 16 * q4 + i, token = tok0 + 63 - t;
        qv[i] = bf2f(hq[(size_t)token * 256 + h * 64 + kk]); vv[i] = bf2f(hv[(size_t)token * 256 + h * 64 + kk]);
      }
      hgrn_gload(WSP(float, OFF_GB), tok0, h, 1, gv);
#pragma unroll
      for (int i = 0; i < 16; ++i) {
        const int token = tok0 + 16 * q4 + i;
        qvN[i] = bf2f(hq[(size_t)token * 256 + h * 64 + kk]); vvN[i] = bf2f(hv[(size_t)token * 256 + h * 64 + kk]);
      }
      hgrn_gload(WSP(float, OFF_GF), tok0, h, 0, gvN);
    } else {
#pragma unroll
      for (int i = 0; i < 16; ++i) { qv[i] = qvN[i]; vv[i] = vvN[i]; gv[i] = gvN[i]; }
    }
    if (tc >= 128) {
#pragma unroll
      for (int e = 0; e < 16; ++e) sv[e] = Sp[tid + 256 * e];
    } else {
#pragma unroll
      for (int e = 0; e < 16; ++e) sv[e] = 0.f;
      for (int ci = 0; ci < pos; ++ci) {
        const int tcp = dir ? cq + 3 - ci : cq + ci; const size_t ip = (size_t)(tcp * 4 + h) * 2 + dir;
        float uu[16], pp[16];
#pragma unroll
        for (int e = 0; e < 16; ++e) { uu[e] = HSb[ip * 4096 + tid + 256 * e]; pp[e] = HPb[ip * 64 + kb + 4 * e]; }
#pragma unroll
        for (int e = 0; e < 16; ++e) sv[e] = pp[e] * sv[e] + uu[e];
      }
      if (pos == 3 && !dry) {
        float* op = P.out + OUT_ST + ((size_t)(((tc >> 2) * 2 + l) * 2 + dir) * 4 + h) * 4096;
#pragma unroll
        for (int e = 0; e < 16; ++e) op[tid + 256 * e] = HPb[idx * 64 + kb + 4 * e] * sv[e] + Sp[tid + 256 * e];
      }
    }
    float dG[16], glm, Mv;
    hgrn_gates_pre(bt, gv, dG, glm, Mv);
    {
#pragma unroll
      for (int i = 0; i < 16; ++i) {
        const int t = 16 * q4 + i;
        QH[t * LD + kk] = f2bf(qv[i] * __expf(fminf(dG[i], 80.f)));
        KH[t * LD + kk] = f2bf((1.f - __expf(gv[i])) * __expf(fminf(-dG[i], 80.f)));
      }
      u32x4 u0, u1;
      u0.x = pk(vv[0], vv[1]); u0.y = pk(vv[2], vv[3]); u0.z = pk(vv[4], vv[5]); u0.w = pk(vv[6], vv[7]);
      u1.x = pk(vv[8], vv[9]); u1.y = pk(vv[10], vv[11]); u1.z = pk(vv[12], vv[13]); u1.w = pk(vv[14], vv[15]);
      *(u32x4*)(VT + kk * LD + 16 * q4) = u0; *(u32x4*)(VT + kk * LD + 16 * q4 + 8) = u1;
      const float emk = __expf(Mv);
      if (q4 == 0) em[kk] = emk;
    }
    __syncthreads();
#pragma unroll
    for (int e = 0; e < 16; ++e) ST[vv0 * LD + kb + 4 * e] = f2bf(sv[e] * em[kb + 4 * e]);
    __syncthreads();
    f32x4 aa[4];
#pragma unroll
    for (int nt = 0; nt < 4; ++nt) aa[nt] = (f32x4){0.f, 0.f, 0.f, 0.f};
    mm64(QH, KH, w, lane, aa);
    __syncthreads();
#pragma unroll
    for (int j = 0; j < 4; ++j) {
      const int t = 16 * w + 4 * quad + j;
#pragma unroll
      for (int nt = 0; nt < 4; ++nt) { const int s = 16 * nt + c; AM[t * LD + s] = f2bf(s <= t ? aa[nt][j] : 0.f); }
    }
    __syncthreads();
    f32x4 acc[4];
#pragma unroll
    for (int nt = 0; nt < 4; ++nt) acc[nt] = (f32x4){0.f, 0.f, 0.f, 0.f};
    mm64(AM, VT, w, lane, acc);
    mm64(QH, ST, w, lane, acc);
    if (dd == 0) {
#pragma unroll
      for (int nt = 0; nt < 4; ++nt) ob[nt] = acc[nt];
    } else {
#pragma unroll
      for (int nt = 0; nt < 4; ++nt) of[nt] = acc[nt];
    }
  }
  __syncthreads();
  float* OB = (float*)smem;
#pragma unroll
  for (int j = 0; j < 4; ++j)
#pragma unroll
    for (int nt = 0; nt < 4; ++nt) OB[(16 * w + 4 * quad + j) * 64 + 16 * nt + c] = ob[nt][j];
  __syncthreads();
  bf16_t* mix = WSP(bf16_t, OFF_MIX);
#pragma unroll
  for (int j = 0; j < 4; ++j) {
    const int t = 16 * w + 4 * quad + j;
    float o[4], ss = 0.f;
#pragma unroll
    for (int nt = 0; nt < 4; ++nt) { o[nt] = of[nt][j] + OB[(63 - t) * 64 + 16 * nt + c]; ss += o[nt] * o[nt]; }
    ss += __shfl_xor(ss, 1); ss += __shfl_xor(ss, 2); ss += __shfl_xor(ss, 4); ss += __shfl_xor(ss, 8);
    const float rinv = rsqrtf(ss * (1.f / 64.f) + 1e-6f);
    bf16_t* dst = mix + (size_t)(tok0 + t) * 1024 + 768 + h * 64 + c;
    if (!dry)
#pragma unroll
    for (int nt = 0; nt < 4; ++nt) dst[16 * nt] = f2bf(o[nt] * rinv * P.hnorm[l * 64 + 16 * nt + c] * bf2f(dst[16 * nt]));
  }
}

DI void phase_mixers(const Params& P, int l, unsigned char* smem, int dry = 0) {
  const int xcd = blockIdx.x & 7, nbx = gridDim.x >> 3;
  for (int j = blockIdx.x >> 3; j < 64; j += nbx) {
    const int b = xcd >> 2;
    if (j < 32) {
      const int hq = 2 * (xcd & 3) + (j >> 4), qb = j & 15, kvh = hq >> 2;
      const int tokq = 8192 + b * 4096 + qb * 256;
      attn_item<0>(P, l, WSP(bf16_t, OFF_QA) + (size_t)tokq * 512 + hq * 64, 512,
                   WSP(bf16_t, OFF_KA_LAT) + (size_t)(l * 2 + b) * 4352 * 128 + kvh * 64, 128,
                   WSP(bf16_t, OFF_VTA_LAT) + ((size_t)(l * 2 + b) * 2 + kvh) * 64 * 4352, 4352,
                   WSP(bf16_t, OFF_MIX) + (size_t)tokq * 1024 + hq * 64, smem, dry);
    } else {
      const int h = xcd & 3, qb = j - 32;
      const int tokq = 8192 + b * 4096 + qb * 128;
      attn_item<1>(P, l, WSP(bf16_t, OFF_QD) + (size_t)tokq * 256 + h * 64, 256,
                   WSP(bf16_t, OFF_KD_LAT) + (size_t)(l * 2 + b) * 4352 * 256 + h * 64, 256,
                   WSP(bf16_t, OFF_VTD_LAT) + ((size_t)(l * 2 + b) * 4 + h) * 64 * 4352, 4352,
                   WSP(bf16_t, OFF_MIX) + (size_t)tokq * 1024 + 512 + h * 64, smem, dry);
    }
  }
  for (int it = blockIdx.x; it < 1536; it += gridDim.x) {
    if (it < 256) {
      const int b = it >> 3, hq = it & 7, kvh = hq >> 2;
      const int tokq = b * 256;
      attn_item<0>(P, l, WSP(bf16_t, OFF_QA) + (size_t)tokq * 512 + hq * 64, 512,
                   WSP(bf16_t, OFF_KA_CTX) + (size_t)b * 256 * 128 + kvh * 64, 128,
                   WSP(bf16_t, OFF_VTA_CTX) + (size_t)(b * 2 + kvh) * 64 * 256, 256,
                   WSP(bf16_t, OFF_MIX) + (size_t)tokq * 1024 + hq * 64, smem, dry);
    } else if (it < 512) {
      const int i2 = it - 256, b = i2 >> 3, h = (i2 >> 1) & 3, qb = i2 & 1;
      const int tokq = b * 256 + qb * 128;
      attn_item<1>(P, l, WSP(bf16_t, OFF_QD) + (size_t)tokq * 256 + h * 64, 256,
                   WSP(bf16_t, OFF_KD_CTX) + (size_t)b * 256 * 256 + h * 64, 256,
                   WSP(bf16_t, OFF_VTD_CTX) + (size_t)(b * 4 + h) * 64 * 256, 256,
                   WSP(bf16_t, OFF_MIX) + (size_t)tokq * 1024 + 512 + h * 64, smem, dry);
    } else hgrn_a_item(P, it - 512, smem);
  }
}

__global__ void __launch_bounds__(NT, 2) fwd_megakernel(Params P) {
  cg::grid_group grid = cg::this_grid();
  extern __shared__ __attribute__((aligned(16))) unsigned char smem[];
  __shared__ uint4 xb_words;
  if (threadIdx.x == 0) xb_words = make_uint4(0u, 0u, 0u, 0u);
  __syncthreads();
  const XcdBarrier xb = xcd_barrier_post(WSP(unsigned, OFF_BAR), (volatile LAS unsigned*)&xb_words);
  if (P.out == nullptr) grid.sync();
#define GSYNC() xcd_barrier(xb)
  for (int it = blockIdx.x; it < P0_ITEMS; it += gridDim.x) p0_item(P, it, smem);
  GSYNC();
  p0b(P);
  GSYNC();
#pragma unroll 1
  for (int l = 0; l < 2; ++l) {
    phase_inproj(P, l, smem);
    GSYNC();
    phase_mixers(P, l, smem);
    GSYNC();
    for (int it = blockIdx.x; it < 1024; it += gridDim.x) hgrn_b_item(P, l, it, smem);
    GSYNC();
    for (int it = blockIdx.x; it < 512; it += gridDim.x) hgrn_c_item(P, l, it, smem);
    GSYNC();
    phase_outproj(P, l, smem);
    GSYNC();
    phase_ln(P, l);
    if (l == 0) GSYNC();
  }
}

extern "C" void kernel_launch(void* const* d_in, const int* in_sizes, int n_in, void* d_out, int out_size,
                              void* d_ws, size_t ws_size, hipStream_t stream) {
  static int grid_blocks = 0;
  if (!grid_blocks) {
    int dev = 0, cus = 0, per_cu = 0;
    (void)hipGetDevice(&dev);
    (void)hipDeviceGetAttribute(&cus, hipDeviceAttributeMultiprocessorCount, dev);
    if (hipFuncSetAttribute((const void*)fwd_megakernel, hipFuncAttributeMaxDynamicSharedMemorySize, SMEM_BYTES) != hipSuccess) fprintf(stderr, "hipFuncSetAttribute failed\n");
    (void)hipOccupancyMaxActiveBlocksPerMultiprocessor(&per_cu, (const void*)fwd_megakernel, NT, SMEM_BYTES);
    if (per_cu < 1) per_cu = 1;
    if (per_cu > 1) per_cu = 1;
    grid_blocks = cus * per_cu;
  }
  if (ws_size < WS_END) { fprintf(stderr, "workspace too small: %zu < %zu\n", ws_size, (size_t)WS_END); return; }
  Params p{};
  const float* const* in = (const float* const*)d_in;
  p.xp = in[0]; p.xs = in[1]; p.cgk = in[2]; p.cgv = in[3]; p.cdk = in[4]; p.cdv = in[5]; p.st = in[6]; p.c = in[7]; p.cctx = in[8];
  p.wada = in[9]; p.bada = in[10]; p.win = in[11]; p.qn = in[12]; p.kn = in[13]; p.dlam = in[14]; p.dsub = in[15]; p.hlb = in[16]; p.hnorm = in[17];
  p.wout = in[18]; p.lng = in[19]; p.lnb = in[20];
  p.out = (float*)d_out; p.ws = (unsigned char*)d_ws;
  (void)hipMemsetAsync((unsigned char*)d_ws + OFF_MOD, 0, 73728, stream);
  (void)hipMemsetAsync((unsigned char*)d_ws + OFF_BAR, 0, XCD_BAR_WORDS * 4, stream);
  void* args[] = {&p};
  hipError_t e = hipLaunchCooperativeKernel((void*)fwd_megakernel, dim3(grid_blocks), dim3(NT), args, SMEM_BYTES, stream);
  if (e != hipSuccess) fprintf(stderr, "cooperative launch failed: %s (grid %d)\n", hipGetErrorString(e), grid_blocks);
}
```
